# Optimizing an MI355X kernel written in HIP

```python
import math
import jax, jax.numpy as jnp
from jax import lax
import numpy as np

D_MODEL = 1024
BATCH = 4
SEQ = 4096
DEPTH = 1

ATT_GROUPS = ((128, 1), (512, 4), (2048, 16))
ATT_HEADS_PER_GROUP = 8
ATT_HEAD_DIM = 64
N_ATT_HEADS = len(ATT_GROUPS) * ATT_HEADS_PER_GROUP
ATT_QKV = N_ATT_HEADS * ATT_HEAD_DIM
ATT_WIDTH = ATT_HEADS_PER_GROUP * ATT_HEAD_DIM
ALIBI_MAX_EXP = 8.0
NEG_INF = -1e30

HGRN_EXPAND = 128
HGRN_HEADS = D_MODEL // HGRN_EXPAND
HGRN_KEY = HGRN_EXPAND
HGRN_VAL = D_MODEL // HGRN_HEADS
HGRN_FDIM = HGRN_HEADS * HGRN_KEY
HGRN_WIDTH = HGRN_HEADS * HGRN_VAL
HGRN_CHUNK = 64

D_FF = ((8 * D_MODEL + 3 * 256 - 1) // (3 * 256)) * 256

DEEPNORM_ALPHA = (2.0 * DEPTH) ** 0.25
DEEPNORM_BETA = (8.0 * DEPTH) ** -0.25
LN_EPS = 1e-5
RMS_EPS = 1e-6

IN_SPLITS = (ATT_QKV, ATT_QKV, ATT_QKV,
             HGRN_FDIM, HGRN_FDIM, HGRN_FDIM,
             HGRN_WIDTH, HGRN_WIDTH,
             D_MODEL, D_MODEL)
IN_COL_SCALE = (1.0, 1.0, DEEPNORM_BETA, 1.0, 1.0, 1.0, DEEPNORM_BETA, 1.0, 1.0, 1.0)
IN_COLS = sum(IN_SPLITS)

kernel_name = "hybrid_dilated_attn_hgrn2_deepnorm_block"


def layer_norm(x, g, b):
    xf = x.astype(jnp.float32)
    mu = jnp.mean(xf, axis=-1, keepdims=True)
    xc = xf - mu
    var = jnp.mean(xc * xc, axis=-1, keepdims=True)
    y = xc * lax.rsqrt(var + LN_EPS) * g.astype(jnp.float32) + b.astype(jnp.float32)
    return y.astype(x.dtype)


def alibi_slopes(n):
    return 2.0 ** (-ALIBI_MAX_EXP * jnp.arange(1, n + 1, dtype=jnp.float32) / n)


def banded_dilated_softmax(q, k, v, half, dil, slopes):
    n, m, h, dh = q.shape
    nb = -(-m // half)
    mp = nb * half
    qb = jnp.pad(q.astype(jnp.float32), ((0, 0), (0, mp - m), (0, 0), (0, 0))).reshape(n, nb, half, h, dh)
    pad_kv = ((0, 0), (half, mp - m + half), (0, 0), (0, 0))

    def band(t):
        tb = jnp.pad(t.astype(jnp.float32), pad_kv).reshape(n, nb + 2, half, h, dh)
        return jnp.concatenate([tb[:, :-2], tb[:, 1:-1], tb[:, 2:]], axis=2)

    kb, vb = band(k), band(v)
    s = jnp.einsum('nbqhd,nbkhd->nbhqk', qb, kb) * (dh ** -0.5)
    q_pos = jnp.arange(half)
    k_off = jnp.arange(3 * half) - half
    rel = k_off[None, :] - q_pos[:, None]
    k_idx = jnp.arange(nb)[:, None] * half + k_off[None, :]
    valid = (jnp.abs(rel) <= half)[None] & ((k_idx >= 0) & (k_idx < m))[:, None, :]
    dist = (dil * jnp.abs(rel)).astype(jnp.float32)
    bias = -slopes.astype(jnp.float32)[:, None, None] * dist[None]
    s = jnp.where(valid[None, :, None], s + bias[None, None], NEG_INF)
    mx = jnp.max(s, axis=-1, keepdims=True)
    p = jnp.exp(s - mx)
    l = jnp.sum(p, axis=-1, keepdims=True)
    o = jnp.einsum('nbhqk,nbkhd->nbqhd', p, vb) / jnp.transpose(l, (0, 1, 3, 2, 4))
    lse = jnp.transpose((mx + jnp.log(l))[..., 0], (0, 1, 3, 2))
    return o.reshape(n, mp, h, dh)[:, :m], lse.reshape(n, mp, h)[:, :m]


def dilated_group(q, k, v, window, dil, slopes):
    b, s, h, dh = q.shape
    m = s // dil
    half = window // (2 * dil)

    def to_res(t):
        return t.reshape(b, m, dil, h, dh).transpose(0, 2, 1, 3, 4).reshape(b * dil, m, h, dh)

    o, lse = banded_dilated_softmax(to_res(q), to_res(k), to_res(v), half, dil, slopes)
    o = o.reshape(b, dil, m, h, dh).transpose(0, 2, 1, 3, 4).reshape(b, s, h, dh)
    lse = lse.reshape(b, dil, m, h).transpose(0, 2, 1, 3).reshape(b, s, h)
    return o, lse


def dilated_attention(aq, ak, av, slopes):
    b, s, _ = aq.shape
    shp = (b, s, len(ATT_GROUPS), ATT_HEADS_PER_GROUP, ATT_HEAD_DIM)
    aq, ak, av = aq.reshape(shp), ak.reshape(shp), av.reshape(shp)
    outs, lses = [], []
    for g, (window, dil) in enumerate(ATT_GROUPS):
        o, lse = dilated_group(aq[:, :, g], ak[:, :, g], av[:, :, g], window, dil, slopes[g])
        outs.append(o)
        lses.append(lse)
    w = jax.nn.softmax(jnp.stack(lses), axis=0)
    o = jnp.sum(w[..., None] * jnp.stack(outs), axis=0)
    return o.reshape(b, s, ATT_WIDTH).astype(aq.dtype)


def gla_chunkwise(q, k, v, logf):
    b, h, s, kd = q.shape
    vd = v.shape[-1]
    c = HGRN_CHUNK
    n = s // c
    q = q.reshape(b, h, n, c, kd)
    k = k.reshape(b, h, n, c, kd)
    v = v.reshape(b, h, n, c, vd)
    cum = jnp.cumsum(logf.reshape(b, h, n, c, kd), axis=3)
    q_dec = q * jnp.exp(cum)
    k_inv = k * jnp.exp(-cum)
    a = jnp.einsum('bhnik,bhnjk->bhnij', q_dec, k_inv)
    causal_in_chunk = jnp.tril(jnp.ones((c, c), dtype=bool))
    a = jnp.where(causal_in_chunk, a, 0.0)
    o_intra = jnp.einsum('bhnij,bhnjv->bhniv', a, v)
    cum_last = cum[..., -1:, :]
    u = jnp.einsum('bhnck,bhncv->bhnkv', k * jnp.exp(cum_last - cum), v)
    decay = jnp.exp(cum_last[..., 0, :])

    def step(state, inp):
        d, uu = inp
        return d[..., None] * state + uu, state

    init = jnp.zeros((b, h, kd, vd), jnp.float32)
    _, s_start = lax.scan(step, init, (jnp.moveaxis(decay, 2, 0), jnp.moveaxis(u, 2, 0)))
    s_start = jnp.moveaxis(s_start, 0, 2)
    o_inter = jnp.einsum('bhnck,bhnkv->bhncv', q_dec, s_start)
    return (o_intra + o_inter).reshape(b, h, s, vd)


def hgrn2(hq, hf_fwd, hf_bwd, hi, hg, lower_bound, norm_g):
    b, s, _ = hq.shape
    H, K, V = HGRN_HEADS, HGRN_KEY, HGRN_VAL

    def heads(t, d):
        return t.astype(jnp.float32).reshape(b, s, H, d).transpose(0, 2, 1, 3)

    q = heads(jax.nn.silu(hq.astype(jnp.float32)), K) * (K ** -0.5)
    v = heads(hi, V)

    def gates(fpre, lb):
        lb = lb.reshape(H, 1, K)
        f = lb + (1.0 - lb) * jax.nn.sigmoid(heads(fpre, K))
        return 1.0 - f, jnp.log(f)

    k_f, lf_f = gates(hf_fwd, lower_bound[0])
    k_b, lf_b = gates(hf_bwd, lower_bound[1])
    flip = lambda t: jnp.flip(t, axis=2)
    o_fwd = gla_chunkwise(q, k_f, v, lf_f)
    o_bwd = flip(gla_chunkwise(flip(q), flip(k_b), flip(v), flip(lf_b)))
    o = (o_fwd + o_bwd).transpose(0, 2, 1, 3)
    o = o * lax.rsqrt(jnp.mean(o * o, axis=-1, keepdims=True) + RMS_EPS) * norm_g.astype(jnp.float32)
    o = o * jax.nn.silu(hg.astype(jnp.float32)).reshape(b, s, H, V)
    return o.reshape(b, s, HGRN_WIDTH).astype(hq.dtype)


def setup_inputs(seed: int = 0) -> dict:
    key = jax.random.key(seed)
    ks = jax.random.split(key, 20)
    f32 = jnp.float32

    def nrm(k, shape, scale):
        return jax.random.normal(k, shape, f32) * scale

    x = nrm(ks[0], (BATCH, SEQ, D_MODEL), 1.0)
    ln_in_g = 1.0 + nrm(ks[1], (D_MODEL,), 0.02)
    ln_in_b = nrm(ks[2], (D_MODEL,), 0.02)
    piece_keys = jax.random.split(ks[3], len(IN_SPLITS))
    w_in = jnp.concatenate(
        [nrm(pk, (DEPTH, D_MODEL, c), (D_MODEL ** -0.5) * sc)
         for pk, c, sc in zip(piece_keys, IN_SPLITS, IN_COL_SCALE)], axis=-1)
    hgrn_lb = nrm(ks[4], (2, DEPTH + 1, HGRN_FDIM), 0.1)
    hgrn_norm_g = 1.0 + nrm(ks[5], (DEPTH, HGRN_VAL), 0.02)
    w_att_up = nrm(ks[6], (DEPTH, ATT_WIDTH, D_MODEL), ATT_WIDTH ** -0.5)
    w_hgrn_up = nrm(ks[7], (DEPTH, HGRN_WIDTH, D_MODEL), HGRN_WIDTH ** -0.5)
    w_o = nrm(ks[8], (DEPTH, D_MODEL, D_MODEL), (D_MODEL ** -0.5) * DEEPNORM_BETA)
    ln1_g = 1.0 + nrm(ks[9], (DEPTH, D_MODEL), 0.02)
    ln1_b = nrm(ks[10], (DEPTH, D_MODEL), 0.02)
    w_ffn_in = nrm(ks[11], (DEPTH, D_MODEL, 2 * D_FF), (D_MODEL ** -0.5) * DEEPNORM_BETA)
    w_ffn_out = nrm(ks[12], (DEPTH, D_FF, D_MODEL), (D_FF ** -0.5) * DEEPNORM_BETA)
    ln2_g = 1.0 + nrm(ks[13], (DEPTH, D_MODEL), 0.02)
    ln2_b = nrm(ks[14], (DEPTH, D_MODEL), 0.02)
    return {"x": x, "ln_in_g": ln_in_g, "ln_in_b": ln_in_b, "w_in": w_in,
            "hgrn_lb": hgrn_lb, "hgrn_norm_g": hgrn_norm_g,
            "w_att_up": w_att_up, "w_hgrn_up": w_hgrn_up, "w_o": w_o,
            "ln1_g": ln1_g, "ln1_b": ln1_b, "w_ffn_in": w_ffn_in, "w_ffn_out": w_ffn_out,
            "ln2_g": ln2_g, "ln2_b": ln2_b}


def reference(x, ln_in_g, ln_in_b, w_in, hgrn_lb, hgrn_norm_g, w_att_up, w_hgrn_up, w_o,
              ln1_g, ln1_b, w_ffn_in, w_ffn_out, ln2_g, ln2_b):
    slopes = alibi_slopes(N_ATT_HEADS).reshape(len(ATT_GROUPS), ATT_HEADS_PER_GROUP)
    lower_bounds = jnp.cumsum(jax.nn.softmax(hgrn_lb.astype(jnp.float32), axis=1), axis=1)
    split_idx = [int(i) for i in np.cumsum(IN_SPLITS)[:-1]]
    h = layer_norm(x, ln_in_g, ln_in_b)
    for l in range(DEPTH):
        proj = h @ w_in[l]
        aq, ak, av, hq, hf_fwd, hf_bwd, hi, hg, ga, gh = jnp.split(proj, split_idx, axis=-1)
        att = dilated_attention(aq, ak, av, slopes)
        rec = hgrn2(hq, hf_fwd, hf_bwd, hi, hg, lower_bounds[:, l], hgrn_norm_g[l])
        merged = jax.nn.sigmoid(ga) * (att @ w_att_up[l]) + jax.nn.sigmoid(gh) * (rec @ w_hgrn_up[l])
        h = layer_norm(DEEPNORM_ALPHA * h + merged @ w_o[l], ln1_g[l], ln1_b[l])
        gate, up = jnp.split(h @ w_ffn_in[l], 2, axis=-1)
        h = layer_norm(DEEPNORM_ALPHA * h + (jax.nn.silu(gate) * up) @ w_ffn_out[l], ln2_g[l], ln2_b[l])
    return h
```

```cpp
#include <hip/hip_runtime.h>
#include <hip/hip_cooperative_groups.h>
#include <cstdio>
namespace cg = cooperative_groups;
namespace pg8 {
#define PG8_LAS __attribute__((address_space(3)))
typedef unsigned short bf16_t;
typedef short bf16x8 __attribute__((ext_vector_type(8)));
typedef float f32x4 __attribute__((ext_vector_type(4)));
typedef unsigned u32x4 __attribute__((ext_vector_type(4)));
constexpr int BM = 256, BK = 64, HALF = 128, HTB = HALF * BK * 2  , STAGE_BYTES = 8 * HTB, NXCD = 8, WGM = 8;

__host__ __device__ __forceinline__ int lds_byte(int r, int c) { const int st = (r >> 4) * 2 + (c >> 5), rr = r & 15, cc = c & 31, ob = rr * 64 + cc * 2; return st * 1024 + (ob ^ (((ob >> 9) & 1) << 5)); }
__host__ __device__ __forceinline__ void stage_rc(int b, int& R, int& C) { const int st = b / 1024, sb = b % 1024, swz = sb ^ (((sb >> 9) & 1) << 5); R = (st >> 1) * 16 + swz / 64; C = (st & 1) * 32 + (swz % 64) / 2; }
__host__ __device__ __forceinline__ int perm32(int rho) { const int n = rho >> 4, i = rho & 15; return 8 * (i >> 2) + 4 * n + (i & 3); }

struct Unit { int pm, pn; };
struct Gemm { const bf16_t* A; const bf16_t* Bt; int M, N, K; };

struct StaticOrder {
    int nM, nN, nwg, G, c;
    __host__ __device__ void init(int M, int N, int G_, int c_) { nM = M / BM; nN = N / BM; nwg = nM * nN; G = G_; c = c_; }
    __host__ __device__ bool next(int i, Unit& u) const {
        const long L = (long)i * G + c; if (L >= nwg) return false;
        int wgid = (int)L; { const int q = nwg / NXCD, r = nwg % NXCD, xcd = wgid % NXCD, off = wgid / NXCD; wgid = (xcd < r ? xcd * (q + 1) : r * (q + 1) + (xcd - r) * q) + off; }
        const int nig = WGM * nN, gid = wgid / nig, fm = gid * WGM, gsz = (nM - fm) < WGM ? (nM - fm) : WGM;
        u.pm = fm + ((wgid % nig) % gsz); u.pn = (wgid % nig) / gsz; return true;
    }
    __device__ __forceinline__ void a_ready(const Unit&) const {}
    __device__ __forceinline__ void done(const Unit&) const {}
};
__device__ __forceinline__ unsigned cvt_pk_bf16(float lo, float hi) { unsigned r; asm volatile("v_cvt_pk_bf16_f32 %0, %1, %2" : "=v"(r) : "v"(lo), "v"(hi)); return r; }
typedef float f32x2 __attribute__((ext_vector_type(2)));
template <class Epi, class Sched, bool STAMP = false>
__device__ __forceinline__ void gemm_phase(PG8_LAS unsigned char* lds, const Gemm g, const Sched& S, const Epi& E, unsigned long long* stamps) {
    const int tid = threadIdx.x, wid = __builtin_amdgcn_readfirstlane(tid >> 6), lane = tid & 63, wr = wid >> 2, wc = wid & 3, fr = lane & 15, fq = lane >> 4;
    const int K = g.K, nt = K / BK;
    int ts_lo = 0, ts_hi = 0, nts = 0; const unsigned long long rt_entry = STAMP ? (unsigned long long)wall_clock64() : 0ull;
#define PG8_STAMP() do { if (STAMP && wid == 0 && nts < 64) { const unsigned long long _c = (unsigned long long)clock64(); \
        ts_lo = (lane == nts) ? (int)(unsigned)_c : ts_lo; ts_hi = (lane == nts) ? (int)(unsigned)(_c >> 32) : ts_hi; ++nts; } } while (0)
    PG8_STAMP();
    unsigned voffA[2], voffB[2];
#pragma unroll
    for (int i = 0; i < 2; ++i) { int R, C; stage_rc(tid * 16 + i * 8192, R, C); const int Rb = Epi::PERM ? ((R & ~31) + perm32(R & 31)) : R;
        voffA[i] = (unsigned)(R * K + C) * 2u; voffB[i] = (unsigned)(Rb * K + C) * 2u; }
    const size_t kstep = (size_t)(BK * 2);
    const size_t hstep = (size_t)HALF * K * 2;
    const size_t tstep = 2 * hstep;
    const unsigned ldsw = (unsigned)wid * 1024u;
    const int aoff = lds_byte(wr * 64 + fr, fq * 8), boff = lds_byte(wc * 32 + fr, fq * 8);
#define PG8_SA(b, h) (((b) * 2 + (h)) * HTB)
#define PG8_SB(b, h) ((4 + (b) * 2 + (h)) * HTB)
#define PG8_STAGE(bufoff, gbase, voff) do { _Pragma("unroll") for (int _i = 0; _i < 2; ++_i) \
        __builtin_amdgcn_global_load_lds((const unsigned*)((const char*)(gbase) + (voff)[_i]), (PG8_LAS unsigned*)(lds + (bufoff) + ldsw + _i * 8192), 16, 0, 0); } while (0)
#define PG8_LDA(dst, b, h) do { _Pragma("unroll") for (int m = 0; m < 4; ++m) _Pragma("unroll") for (int k = 0; k < 2; ++k) dst[m][k] = *(const PG8_LAS bf16x8*)(lds + PG8_SA(b, h) + aoff + m * 2048 + k * 1024); } while (0)
#define PG8_LDB(dst, b, h) do { _Pragma("unroll") for (int n = 0; n < 2; ++n) _Pragma("unroll") for (int k = 0; k < 2; ++k) dst[n][k] = *(const PG8_LAS bf16x8*)(lds + PG8_SB(b, h) + boff + n * 2048 + k * 1024); } while (0)
#define PG8_MMA(ai, bj, At, Bt) do { __builtin_amdgcn_s_setprio(1); _Pragma("unroll") for (int m = 0; m < 4; ++m) _Pragma("unroll") for (int n = 0; n < 2; ++n) _Pragma("unroll") for (int k = 0; k < 2; ++k) \
        acc[ai][bj][m][n] = __builtin_amdgcn_mfma_f32_16x16x32_bf16(Bt[n][k], At[m][k], acc[ai][bj][m][n], 0, 0, 0); __builtin_amdgcn_s_setprio(0); } while (0)
#define PG8_WAIT_V(n) asm volatile("s_waitcnt vmcnt(" #n ")" ::: "memory")
#define PG8_WAIT_L(n) asm volatile("s_waitcnt lgkmcnt(" #n ")" ::: "memory")
#define PG8_BAR __builtin_amdgcn_s_barrier()
#define PG8_SCHED __builtin_amdgcn_sched_barrier(0)
    Unit cur, nxt; int ui = 0;
    if (!S.next(0, cur)) return;
    f32x4 acc[2][2][4][2];
#pragma unroll
    for (int a = 0; a < 2; ++a)
#pragma unroll
        for (int b = 0; b < 2; ++b)
#pragma unroll
            for (int m = 0; m < 4; ++m)
#pragma unroll
                for (int n = 0; n < 2; ++n) acc[a][b][m][n] = (f32x4){0.f, 0.f, 0.f, 0.f};
    bf16x8 At[4][2], B0[2][2], B1[2][2];
    const char* cA = (const char*)g.A + (size_t)cur.pm * tstep; const char* cB = (const char*)g.Bt + (size_t)cur.pn * tstep;
    S.a_ready(cur);
    PG8_STAGE(PG8_SB(0, 0), cB, voffB); PG8_STAGE(PG8_SA(0, 0), cA, voffA); PG8_STAGE(PG8_SB(0, 1), cB + hstep, voffB); PG8_STAGE(PG8_SA(0, 1), cA + hstep, voffA);
    if (wr == 1) PG8_BAR;
    PG8_WAIT_V(4); PG8_BAR;
    PG8_STAGE(PG8_SB(1, 0), cB + kstep, voffB); PG8_STAGE(PG8_SA(1, 0), cA + kstep, voffA); PG8_STAGE(PG8_SB(1, 1), cB + hstep + kstep, voffB);
    PG8_WAIT_V(6); PG8_BAR;
    PG8_STAMP();
    for (;;) {
        const bool has_next = S.next(ui + 1, nxt);
        const char* nA = has_next ? (const char*)g.A + (size_t)nxt.pm * tstep : cA; const char* nB = has_next ? (const char*)g.Bt + (size_t)nxt.pn * tstep : cB;
        for (int t = 0; t < nt; t += 2) {
            const bool last = (t == nt - 2);
            const char* a1 = cA + (size_t)(t + 1) * kstep;
            const char* a2 = last ? nA : cA + (size_t)(t + 2) * kstep; const char* b2 = last ? nB : cB + (size_t)(t + 2) * kstep;
            const char* a3 = a2 + kstep; const char* b3 = b2 + kstep;
            if (last && has_next) S.a_ready(nxt);
            PG8_LDB(B0, 0, 0); PG8_SCHED; PG8_LDA(At, 0, 0); PG8_STAGE(PG8_SA(1, 1), a1 + hstep, voffA);
            PG8_WAIT_L(8); PG8_BAR; PG8_WAIT_L(0); PG8_MMA(0, 0, At, B0); PG8_BAR; PG8_SCHED;
            PG8_LDB(B1, 0, 1); PG8_STAGE(PG8_SB(0, 0), b2, voffB);
            PG8_BAR; PG8_WAIT_L(0); PG8_MMA(0, 1, At, B1); PG8_BAR;
            PG8_LDA(At, 0, 1); PG8_STAGE(PG8_SA(0, 0), a2, voffA);
            PG8_BAR; PG8_WAIT_L(0); PG8_MMA(1, 0, At, B0); PG8_BAR; PG8_SCHED;
            PG8_STAGE(PG8_SB(0, 1), b2 + hstep, voffB);
            PG8_WAIT_V(6); PG8_BAR; PG8_MMA(1, 1, At, B1); PG8_BAR;
            PG8_LDB(B0, 1, 0); PG8_SCHED; PG8_LDA(At, 1, 0); PG8_STAGE(PG8_SA(0, 1), a2 + hstep, voffA);
            PG8_WAIT_L(8); PG8_BAR; PG8_WAIT_L(0); PG8_MMA(0, 0, At, B0); PG8_BAR; PG8_SCHED;
            PG8_LDB(B1, 1, 1); PG8_STAGE(PG8_SB(1, 0), b3, voffB);
            PG8_BAR; PG8_WAIT_L(0); PG8_MMA(0, 1, At, B1); PG8_BAR;
            PG8_LDA(At, 1, 1); PG8_STAGE(PG8_SA(1, 0), a3, voffA);
            PG8_BAR; PG8_WAIT_L(0); PG8_MMA(1, 0, At, B0); PG8_BAR; PG8_SCHED;
            PG8_STAGE(PG8_SB(1, 1), b3 + hstep, voffB);
            PG8_WAIT_V(6); PG8_BAR; PG8_MMA(1, 1, At, B1); PG8_BAR;
        }
        PG8_STAMP();
        if constexpr (!Epi::AFTER_DRAIN) { E(acc, cur, wr, wc, fr, fq); S.done(cur); }
        PG8_STAMP();
        if (!has_next) break;
#pragma unroll
        for (int a = 0; a < 2; ++a)
#pragma unroll
            for (int b = 0; b < 2; ++b)
#pragma unroll
                for (int m = 0; m < 4; ++m)
#pragma unroll
                    for (int n = 0; n < 2; ++n) acc[a][b][m][n] = (f32x4){0.f, 0.f, 0.f, 0.f};
        cur = nxt; cA = nA; cB = nB; ++ui;
    }
    PG8_WAIT_V(0);
    if (wr == 0) PG8_BAR;
    PG8_BAR;
    if constexpr (Epi::AFTER_DRAIN) { E.fused(acc, cur, wr, wc, fr, fq, lds, wid, lane); S.done(cur); }
    PG8_STAMP();
    if (STAMP && wid == 0) { stamps[lane] = lane < nts ? (((unsigned long long)(unsigned)ts_hi << 32) | (unsigned)ts_lo) : 0ull;
        if (lane == 62) stamps[62] = rt_entry; if (lane == 63) stamps[63] = (unsigned long long)wall_clock64(); }
#undef PG8_STAMP
#undef PG8_SA
#undef PG8_SB
#undef PG8_STAGE
#undef PG8_LDA
#undef PG8_LDB
#undef PG8_MMA
#undef PG8_WAIT_V
#undef PG8_WAIT_L
#undef PG8_BAR
#undef PG8_SCHED
}
}
using pg8::bf16_t; using pg8::bf16x8; using pg8::f32x4; using pg8::u32x4; using pg8::Unit;
#define LAS __attribute__((address_space(3)))
typedef float f32x2 __attribute__((ext_vector_type(2)));
typedef unsigned u32x2 __attribute__((ext_vector_type(2)));

constexpr int TOK = 16384, DM = 1024, SEQ = 4096, DFF = 2816;
constexpr float ALPHA = 1.189207115002721f;
constexpr float LN_EPS = 1e-5f, RMS_EPS = 1e-6f;
constexpr size_t MiB = (size_t)1 << 20;
constexpr size_t WS_STATS = 0, WS_LSE = 1 * MiB, WS_WTIN = 3 * MiB, WS_WTA = 26 * MiB, WS_WTR = 27 * MiB, WS_WTO = 29 * MiB,
                 WS_WTF1 = 31 * MiB, WS_WTF2 = 42 * MiB, WS_R = 48 * MiB, WS_O = 192 * MiB;
constexpr int LDS_BYTES = 147456;
constexpr int NPHASE = 12;

typedef float f32x2_t __attribute__((ext_vector_type(2)));
typedef __bf16 bf16v2_t __attribute__((ext_vector_type(2)));
__device__ __forceinline__ unsigned pk2(float lo, float hi) { f32x2_t v = {lo, hi}; bf16v2_t b = __builtin_convertvector(v, bf16v2_t); return __builtin_bit_cast(unsigned, b); }
__device__ __forceinline__ unsigned short f2bf(float f) { return (unsigned short)(pk2(f, 0.f) & 0xffffu); }
__device__ __forceinline__ float bf2f(unsigned short b) { return __uint_as_float(((unsigned)b) << 16); }
__device__ __forceinline__ float bflo(unsigned w) { return __uint_as_float(w << 16); }
__device__ __forceinline__ float bfhi(unsigned w) { return __uint_as_float(w & 0xffff0000u); }
__device__ __forceinline__ float sigmoidf_(float x) { return 1.0f / (1.0f + __expf(-x)); }
__device__ __forceinline__ float siluf_(float x) { return x / (1.0f + __expf(-x)); }
__device__ __forceinline__ float wave_sum(float v) {
#pragma unroll
    for (int o = 1; o < 64; o <<= 1) v += __shfl_xor(v, o);
    return v;
}
#define LDS_WAIT() asm volatile("s_waitcnt lgkmcnt(0)" ::: "memory")

__device__ __forceinline__ u32x4 pack8(const f32x4& a, const f32x4& b) { u32x4 w; w.x = pk2(a[0], a[1]); w.y = pk2(a[2], a[3]); w.z = pk2(b[0], b[1]); w.w = pk2(b[2], b[3]); return w; }
__device__ __forceinline__ void unpack8(const u32x4& w, f32x4& a, f32x4& b) { a[0] = bflo(w.x); a[1] = bfhi(w.x); a[2] = bflo(w.y); a[3] = bfhi(w.y); b[0] = bflo(w.z); b[1] = bfhi(w.z); b[2] = bflo(w.w); b[3] = bfhi(w.w); }

struct EpiHg {
    static constexpr bool PERM = true, AFTER_DRAIN = false;
    bf16_t* G; bf16_t* SHG;
    __device__ __forceinline__ void operator()(const f32x4 (&acc)[2][2][4][2], const Unit& u, int wr, int wc, int fr, int fq) const {
        const int sec = u.pn >> 2;
        bf16_t* base = sec < 4 ? G : SHG; const int ld = sec < 4 ? 4096 : 1024; const int colt = sec < 4 ? u.pn * 256 : (u.pn - 16) * 256;
        const int row0 = u.pm * 256 + wr * 64 + fr, col0 = colt + wc * 32 + 8 * fq;
#pragma unroll
        for (int ai = 0; ai < 2; ++ai)
#pragma unroll
            for (int m = 0; m < 4; ++m) { bf16_t* rowp = base + (size_t)(row0 + ai * 128 + m * 16) * ld + col0;
#pragma unroll
                for (int bj = 0; bj < 2; ++bj) { f32x4 v0 = acc[ai][bj][m][0], v1 = acc[ai][bj][m][1];
                    if (sec == 0) {
#pragma unroll
                        for (int j = 0; j < 4; ++j) { v0[j] = siluf_(v0[j]) * 0.08838834764831845f; v1[j] = siluf_(v1[j]) * 0.08838834764831845f; } }
                    else if (sec == 4) {
#pragma unroll
                        for (int j = 0; j < 4; ++j) { v0[j] = siluf_(v0[j]); v1[j] = siluf_(v1[j]); } }
                    *(u32x4*)(rowp + bj * 128) = pack8(v0, v1); } }
    }
};
struct EpiQKV {
    static constexpr bool PERM = true, AFTER_DRAIN = false;
    bf16_t* QKV;
    __device__ __forceinline__ void operator()(const f32x4 (&acc)[2][2][4][2], const Unit& u, int wr, int wc, int fr, int fq) const {
        const int t = u.pn / 6; const int colt = (u.pn - 6 * t) * 256; const float sc = t == 0 ? 0.125f : 1.0f;
        bf16_t* base = QKV + (size_t)t * TOK * 1536;
        const int row0 = u.pm * 256 + wr * 64 + fr, col0 = colt + wc * 32 + 8 * fq;
#pragma unroll
        for (int ai = 0; ai < 2; ++ai)
#pragma unroll
            for (int m = 0; m < 4; ++m) { bf16_t* rowp = base + (size_t)(row0 + ai * 128 + m * 16) * 1536 + col0;
#pragma unroll
                for (int bj = 0; bj < 2; ++bj) *(u32x4*)(rowp + bj * 128) = pack8(acc[ai][bj][m][0] * sc, acc[ai][bj][m][1] * sc); }
    }
};
template <int MODE> struct EpiMix {
    static constexpr bool PERM = true, AFTER_DRAIN = false;
    bf16_t* O; const bf16_t* G2;
    __device__ __forceinline__ void operator()(const f32x4 (&acc)[2][2][4][2], const Unit& u, int wr, int wc, int fr, int fq) const {
        const int row0 = u.pm * 256 + wr * 64 + fr, col0 = u.pn * 256 + wc * 32 + 8 * fq;
#pragma unroll
        for (int ai = 0; ai < 2; ++ai)
#pragma unroll
            for (int m = 0; m < 4; ++m) { const size_t off = (size_t)(row0 + ai * 128 + m * 16) * 1024 + col0;
#pragma unroll
                for (int bj = 0; bj < 2; ++bj) { f32x4 v0 = acc[ai][bj][m][0], v1 = acc[ai][bj][m][1];
                    if (MODE == 0) {
#pragma unroll
                        for (int j = 0; j < 4; ++j) { v0[j] = sigmoidf_(v0[j]); v1[j] = sigmoidf_(v1[j]); } }
                    if (MODE == 1) { f32x4 p0, p1; unpack8(*(const u32x4*)(O + off + bj * 128), p0, p1); v0 = p0 * v0; v1 = p1 * v1; }
                    if (MODE == 2) { f32x4 p0, p1, g0, g1; unpack8(*(const u32x4*)(O + off + bj * 128), p0, p1); unpack8(*(const u32x4*)(G2 + off + bj * 128), g0, g1); v0 = p0 + g0 * v0; v1 = p1 + g1 * v1; }
                    *(u32x4*)(O + off + bj * 128) = pack8(v0, v1); } }
    }
};
struct EpiWo {
    static constexpr bool PERM = false, AFTER_DRAIN = false;
    const float* x; const f32x2* stats; const float* g; const float* b; float* Y;
    __device__ __forceinline__ void operator()(const f32x4 (&acc)[2][2][4][2], const Unit& u, int wr, int wc, int fr, int fq) const {
        const int row0 = u.pm * 256 + wr * 64 + fr, col0 = u.pn * 256 + wc * 32 + 4 * fq;
        f32x4 gv[2][2], bv[2][2];
#pragma unroll
        for (int bj = 0; bj < 2; ++bj)
#pragma unroll
            for (int n = 0; n < 2; ++n) { gv[bj][n] = *(const f32x4*)(g + col0 + bj * 128 + n * 16) * ALPHA; bv[bj][n] = *(const f32x4*)(b + col0 + bj * 128 + n * 16) * ALPHA; }
#pragma unroll
        for (int ai = 0; ai < 2; ++ai)
#pragma unroll
            for (int m = 0; m < 4; ++m) { const int row = row0 + ai * 128 + m * 16; const f32x2 st = stats[row]; const size_t off = (size_t)row * 1024 + col0;
#pragma unroll
                for (int bj = 0; bj < 2; ++bj)
#pragma unroll
                    for (int n = 0; n < 2; ++n) { const f32x4 xv = *(const f32x4*)(x + off + bj * 128 + n * 16);
                        *(f32x4*)(Y + off + bj * 128 + n * 16) = (xv - st.x) * st.y * gv[bj][n] + bv[bj][n] + acc[ai][bj][m][n]; }
                asm volatile("" ::: "memory"); }
    }
};
struct EpiFfnIn {
    static constexpr bool PERM = true, AFTER_DRAIN = false;
    bf16_t* ACT;
    __device__ __forceinline__ void operator()(const f32x4 (&acc)[2][2][4][2], const Unit& u, int wr, int wc, int fr, int fq) const {
        const int row0 = u.pm * 256 + wr * 64 + fr, col0 = u.pn * 128 + wc * 32 + 8 * fq;
#pragma unroll
        for (int ai = 0; ai < 2; ++ai)
#pragma unroll
            for (int m = 0; m < 4; ++m) { f32x4 v0, v1;
#pragma unroll
                for (int j = 0; j < 4; ++j) { v0[j] = siluf_(acc[ai][0][m][0][j]) * acc[ai][1][m][0][j]; v1[j] = siluf_(acc[ai][0][m][1][j]) * acc[ai][1][m][1][j]; }
                *(u32x4*)(ACT + (size_t)(row0 + ai * 128 + m * 16) * DFF + col0) = pack8(v0, v1); }
    }
};
struct EpiFfnOut {
    static constexpr bool PERM = false, AFTER_DRAIN = false;
    const float* H1; float* Y;
    __device__ __forceinline__ void operator()(const f32x4 (&acc)[2][2][4][2], const Unit& u, int wr, int wc, int fr, int fq) const {
        const int row0 = u.pm * 256 + wr * 64 + fr, col0 = u.pn * 256 + wc * 32 + 4 * fq;
#pragma unroll
        for (int ai = 0; ai < 2; ++ai)
#pragma unroll
            for (int m = 0; m < 4; ++m) { const size_t off = (size_t)(row0 + ai * 128 + m * 16) * 1024 + col0;
#pragma unroll
                for (int bj = 0; bj < 2; ++bj)
#pragma unroll
                    for (int n = 0; n < 2; ++n) { const f32x4 hv = *(const f32x4*)(H1 + off + bj * 128 + n * 16);
                        *(f32x4*)(Y + off + bj * 128 + n * 16) = hv * ALPHA + acc[ai][bj][m][n]; }
                asm volatile("" ::: "memory"); }
    }
};

__device__ __forceinline__ void tr_item(const float* __restrict__ W, int ldw, int k0, int c0, bf16_t* WT, int K, int r0, LAS float* scr, int lane) {
#pragma unroll 8
    for (int i = 0; i < 32; ++i) { const int kk = 2 * i + (lane >> 5); scr[kk * 33 + (lane & 31)] = W[(size_t)(k0 + kk) * ldw + c0 + (lane & 31)]; }
    LDS_WAIT();
    const int c = lane & 7;
#pragma unroll
    for (int j = 0; j < 4; ++j) { const int n = (lane >> 3) + 8 * j; const LAS float* s = scr + (8 * c) * 33 + n;
        u32x4 o; o.x = pk2(s[0 * 33], s[1 * 33]); o.y = pk2(s[2 * 33], s[3 * 33]); o.z = pk2(s[4 * 33], s[5 * 33]); o.w = pk2(s[6 * 33], s[7 * 33]);
        *(u32x4*)(WT + (size_t)(r0 + n) * K + k0 + 8 * c) = o; }
    LDS_WAIT();
}
template <bool WF32, bool WBF16, bool WSTATS>
__device__ __forceinline__ void ln_row(const float* in, const float* g, const float* b, float* outf, bf16_t* outb, f32x2* stat, int lane) {
    const f32x4* xr = (const f32x4*)in + lane;
    f32x4 v[4]; float s = 0.f;
#pragma unroll
    for (int j = 0; j < 4; ++j) { v[j] = xr[64 * j]; s += (v[j][0] + v[j][1]) + (v[j][2] + v[j][3]); }
    const float mean = wave_sum(s) * (1.f / 1024.f); float s2 = 0.f;
#pragma unroll
    for (int j = 0; j < 4; ++j) { v[j] = v[j] - mean; s2 += (v[j][0] * v[j][0] + v[j][1] * v[j][1]) + (v[j][2] * v[j][2] + v[j][3] * v[j][3]); }
    const float rstd = 1.0f / sqrtf(wave_sum(s2) * (1.f / 1024.f) + LN_EPS);
    if (WSTATS && lane == 0) *stat = (f32x2){mean, rstd};
#pragma unroll
    for (int j = 0; j < 4; ++j) { const f32x4 gv = ((const f32x4*)g)[lane + 64 * j], bv = ((const f32x4*)b)[lane + 64 * j];
        const f32x4 y = v[j] * rstd * gv + bv;
        if (WF32) ((f32x4*)outf)[lane + 64 * j] = y;
        if (WBF16) { u32x2 w; w.x = pk2(y[0], y[1]); w.y = pk2(y[2], y[3]); ((u32x2*)outb)[lane + 64 * j] = w; } }
}
#define MFMA16(a, b, c) __builtin_amdgcn_mfma_f32_16x16x32_bf16((a), (b), (c), 0, 0, 0)

__device__ __forceinline__ void hgrn_phase(LAS unsigned char* lds, const bf16_t* __restrict__ G, const float* __restrict__ lbraw, bf16_t* __restrict__ OFB, int tid, int lane, int wave) {
    LAS unsigned char* sQ = lds;
    LAS unsigned char* sKi = lds + 17408;
    LAS unsigned char* sKdT = lds + 34816;
    LAS unsigned char* sVT = lds + 53248;
    LAS unsigned char* sA = lds + 57856;
    LAS unsigned char* sST = lds + 67072;
    LAS float* sTot = (LAS float*)(lds + 75776);
    LAS float* sDec = (LAS float*)(lds + 77824);
    const int fr = lane & 15, fq = lane >> 4;
    const int kcol = tid & 127, rg = tid >> 7;
    const int vj = tid >> 3, vc4 = tid & 7;
    for (int it = blockIdx.x; it < 256; it += gridDim.x) {
        const int vs = it & 3, dir = (it >> 2) & 1, h = (it >> 3) & 7, b = it >> 6;
        const float a0 = lbraw[dir * 2048 + h * 128 + kcol], a1 = lbraw[dir * 2048 + 1024 + h * 128 + kcol];
        const float lb = 1.0f / (1.0f + __expf(a1 - a0)), oml = 1.0f - lb;
        const bf16_t* Gb = G + (size_t)b * SEQ * 4096;
        bf16_t* Ob = OFB + (size_t)dir * TOK * 1024 + (size_t)b * SEQ * 1024 + h * 128 + vs * 32;
        const int qoff = h * 128 + kcol, foff = 1024 + dir * 1024 + h * 128 + kcol, voff = 3072 + h * 128 + vs * 32 + vc4 * 4;
        f32x4 Sacc[2]; Sacc[0] = (f32x4){0.f, 0.f, 0.f, 0.f}; Sacc[1] = Sacc[0];
        __syncthreads();
        for (int e = tid; e < 2176; e += 512) ((LAS unsigned*)sST)[e] = 0u;
        unsigned short qn[16], fn[16]; u32x2 vn;
        {
#pragma unroll
            for (int ii = 0; ii < 16; ++ii) { const int i = rg * 16 + ii; const int t = dir ? (SEQ - 1 - i) : i; qn[ii] = Gb[(size_t)t * 4096 + qoff]; fn[ii] = Gb[(size_t)t * 4096 + foff]; }
            const int t = dir ? (SEQ - 1 - vj) : vj; vn = *(const u32x2*)(Gb + (size_t)t * 4096 + voff);
        }
        __syncthreads();
        for (int n = 0; n < 64; ++n) {
            float cum[16], kk[16], qq[16]; float run = 0.f;
#pragma unroll
            for (int ii = 0; ii < 16; ++ii) { const float x = bf2f(fn[ii]); const float e = __expf(-fabsf(x)); const float sa = 1.0f / (1.0f + e), sbm = e * sa; const float sg = x >= 0.f ? sa : sbm, om = x >= 0.f ? sbm : sa;
                const float f = lb + oml * sg; kk[ii] = oml * om; run += __logf(f); cum[ii] = run; qq[ii] = bf2f(qn[ii]); }
            const u32x2 vcur = vn;
            if (n + 1 < 64) {
#pragma unroll
                for (int ii = 0; ii < 16; ++ii) { const int i = (n + 1) * 64 + rg * 16 + ii; const int t = dir ? (SEQ - 1 - i) : i; qn[ii] = Gb[(size_t)t * 4096 + qoff]; fn[ii] = Gb[(size_t)t * 4096 + foff]; }
                const int i = (n + 1) * 64 + vj; const int t = dir ? (SEQ - 1 - i) : i; vn = *(const u32x2*)(Gb + (size_t)t * 4096 + voff);
            }
            sTot[rg * 128 + kcol] = run;
            __syncthreads();
            float off = 0.f, tot = 0.f;
#pragma unroll
            for (int g2 = 0; g2 < 4; ++g2) { const float t = sTot[g2 * 128 + kcol]; tot += t; off += (g2 < rg) ? t : 0.f; }
            float kd[16];
#pragma unroll
            for (int ii = 0; ii < 16; ++ii) { const float c = cum[ii] + off; const int i = rg * 16 + ii;
                *(LAS unsigned short*)(sQ + i * 272 + kcol * 2) = f2bf(qq[ii] * __expf(c));
                *(LAS unsigned short*)(sKi + i * 272 + kcol * 2) = f2bf(kk[ii] * __expf(-c));
                kd[ii] = kk[ii] * __expf(tot - c); }
            { u32x4 w0, w1; w0.x = pk2(kd[0], kd[1]); w0.y = pk2(kd[2], kd[3]); w0.z = pk2(kd[4], kd[5]); w0.w = pk2(kd[6], kd[7]);
              w1.x = pk2(kd[8], kd[9]); w1.y = pk2(kd[10], kd[11]); w1.z = pk2(kd[12], kd[13]); w1.w = pk2(kd[14], kd[15]);
              *(LAS u32x4*)(sKdT + kcol * 144 + rg * 32) = w0; *(LAS u32x4*)(sKdT + kcol * 144 + rg * 32 + 16) = w1; }
            if (rg == 0) sDec[kcol] = __expf(tot);
            { LAS unsigned char* p = sVT + (vc4 * 4) * 144 + vj * 2;
              *(LAS unsigned short*)(p) = (unsigned short)(vcur.x & 0xffffu); *(LAS unsigned short*)(p + 144) = (unsigned short)(vcur.x >> 16);
              *(LAS unsigned short*)(p + 288) = (unsigned short)(vcur.y & 0xffffu); *(LAS unsigned short*)(p + 432) = (unsigned short)(vcur.y >> 16); }
            __syncthreads();
            const int ti = wave >> 1, tv = wave & 1;
#pragma unroll
            for (int t2 = 0; t2 < 2; ++t2) { const int tj = (wave & 1) * 2 + t2;
                f32x4 a = (f32x4){0.f, 0.f, 0.f, 0.f};
                if (tj <= ti) {
#pragma unroll
                    for (int ks = 0; ks < 4; ++ks) { const bf16x8 A = *(const LAS bf16x8*)(sQ + (ti * 16 + fr) * 272 + fq * 16 + ks * 64);
                        const bf16x8 B = *(const LAS bf16x8*)(sKi + (tj * 16 + fr) * 272 + fq * 16 + ks * 64); a = MFMA16(A, B, a); } }
#pragma unroll
                for (int jj = 0; jj < 4; ++jj) { const int i = ti * 16 + fq * 4 + jj, j = tj * 16 + fr;
                    const float val = (j <= i) ? a[jj] : 0.f; *(LAS unsigned short*)(sA + i * 144 + j * 2) = f2bf(val); } }
            f32x4 o = (f32x4){0.f, 0.f, 0.f, 0.f};
#pragma unroll
            for (int ks = 0; ks < 4; ++ks) { const bf16x8 A = *(const LAS bf16x8*)(sQ + (ti * 16 + fr) * 272 + fq * 16 + ks * 64);
                const bf16x8 B = *(const LAS bf16x8*)(sST + (tv * 16 + fr) * 272 + fq * 16 + ks * 64); o = MFMA16(A, B, o); }
            __syncthreads();
#pragma unroll
            for (int ks = 0; ks < 2; ++ks) { const bf16x8 A = *(const LAS bf16x8*)(sA + (ti * 16 + fr) * 144 + fq * 16 + ks * 64);
                const bf16x8 B = *(const LAS bf16x8*)(sVT + (tv * 16 + fr) * 144 + fq * 16 + ks * 64); o = MFMA16(A, B, o); }
#pragma unroll
            for (int jj = 0; jj < 4; ++jj) { const int i = n * 64 + ti * 16 + fq * 4 + jj; const int t = dir ? (SEQ - 1 - i) : i;
                Ob[(size_t)t * 1024 + tv * 16 + fr] = f2bf(o[jj]); }
#pragma unroll
            for (int jj = 0; jj < 4; ++jj) { const float d = sDec[16 * wave + fq * 4 + jj]; Sacc[0][jj] *= d; Sacc[1][jj] *= d; }
#pragma unroll
            for (int ks = 0; ks < 2; ++ks) { const bf16x8 A = *(const LAS bf16x8*)(sKdT + (16 * wave + fr) * 144 + fq * 16 + ks * 64);
#pragma unroll
                for (int t2 = 0; t2 < 2; ++t2) { const bf16x8 B = *(const LAS bf16x8*)(sVT + (t2 * 16 + fr) * 144 + fq * 16 + ks * 64); Sacc[t2] = MFMA16(A, B, Sacc[t2]); } }
#pragma unroll
            for (int t2 = 0; t2 < 2; ++t2) { u32x2 w; w.x = pk2(Sacc[t2][0], Sacc[t2][1]); w.y = pk2(Sacc[t2][2], Sacc[t2][3]);
                *(LAS u32x2*)(sST + (t2 * 16 + fr) * 272 + (16 * wave + fq * 4) * 2) = w; }
            __syncthreads();
        }
    }
}

__device__ __forceinline__ void attn_phase(LAS unsigned char* lds, bf16_t* Q, const bf16_t* __restrict__ K, const bf16_t* __restrict__ V, float* __restrict__ LSE, int tid, int lane, int wave) {
    LAS unsigned char* sK = lds;
    LAS unsigned char* sVT = lds + 39168;
    const int fr = lane & 15, fq = lane >> 4;
    for (int it = blockIdx.x; it < 3072; it += gridDim.x) {
        const int g = it >> 10, rem = it & 1023, b = rem >> 8, h = (rem >> 5) & 7, sb = rem & 31;
        const int dsh = 2 * g, dil = 1 << dsh, m = SEQ >> dsh, spb = 32 >> dsh;
        const int r = sb >> (5 - dsh), q0 = (sb & (spb - 1)) * 128;
        const int colbase = g * 512 + h * 64;
        __syncthreads();
        for (int e = tid; e < 2176; e += 512) { const int j = e >> 3, c = e & 7; const int kx = q0 - 64 + j; const bool valid = kx >= 0 && kx < m;
            const size_t off = (size_t)(b * SEQ + (valid ? kx : 0) * dil + r) * 1536 + colbase + c * 8;
            u32x4 kv = *(const u32x4*)(K + off), vv = *(const u32x4*)(V + off);
            if (!valid) { kv = (u32x4){0u, 0u, 0u, 0u}; vv = kv; }
            *(LAS u32x4*)(sK + j * 144 + c * 16) = kv;
            LAS unsigned char* p = sVT + (c * 8) * 552 + j * 2;
            *(LAS unsigned short*)(p + 0 * 552) = (unsigned short)(vv.x & 0xffffu); *(LAS unsigned short*)(p + 1 * 552) = (unsigned short)(vv.x >> 16);
            *(LAS unsigned short*)(p + 2 * 552) = (unsigned short)(vv.y & 0xffffu); *(LAS unsigned short*)(p + 3 * 552) = (unsigned short)(vv.y >> 16);
            *(LAS unsigned short*)(p + 4 * 552) = (unsigned short)(vv.z & 0xffffu); *(LAS unsigned short*)(p + 5 * 552) = (unsigned short)(vv.z >> 16);
            *(LAS unsigned short*)(p + 6 * 552) = (unsigned short)(vv.w & 0xffffu); *(LAS unsigned short*)(p + 7 * 552) = (unsigned short)(vv.w >> 16); }
        const int qtok = b * SEQ + (q0 + 16 * wave + fr) * dil + r;
        bf16_t* qrow = Q + (size_t)qtok * 1536 + colbase;
        bf16x8 qf[2]; qf[0] = *(const bf16x8*)(qrow + fq * 8); qf[1] = *(const bf16x8*)(qrow + fq * 8 + 32);
        __syncthreads();
        f32x4 s[10];
#pragma unroll
        for (int kt = 0; kt < 10; ++kt) { f32x4 a = (f32x4){0.f, 0.f, 0.f, 0.f};
#pragma unroll
            for (int ks = 0; ks < 2; ++ks) { const bf16x8 A = *(const LAS bf16x8*)(sK + (16 * (wave + kt) + fr) * 144 + fq * 16 + ks * 64); a = MFMA16(A, qf[ks], a); }
            s[kt] = a; }
        const float sd = exp2f(-(float)(g * 8 + h + 1) * (1.0f / 3.0f)) * (float)dil;
        float mx = -1e30f;
#pragma unroll
        for (int kt = 0; kt < 10; ++kt)
#pragma unroll
            for (int jj = 0; jj < 4; ++jj) { const int rel = -64 + 16 * kt + fq * 4 + jj - fr; const int kx = q0 - 64 + 16 * (wave + kt) + fq * 4 + jj;
                const int ar = rel < 0 ? -rel : rel; const bool valid = ar <= 64 && kx >= 0 && kx < m;
                const float v = valid ? s[kt][jj] - sd * (float)ar : -1e30f; s[kt][jj] = v; mx = fmaxf(mx, v); }
        mx = fmaxf(mx, __shfl_xor(mx, 16)); mx = fmaxf(mx, __shfl_xor(mx, 32));
        float lsum = 0.f;
#pragma unroll
        for (int kt = 0; kt < 10; ++kt)
#pragma unroll
            for (int jj = 0; jj < 4; ++jj) { const float p = __expf(s[kt][jj] - mx); s[kt][jj] = p; lsum += p; }
        lsum += __shfl_xor(lsum, 16); lsum += __shfl_xor(lsum, 32);
        f32x4 o[4];
#pragma unroll
        for (int dt = 0; dt < 4; ++dt) o[dt] = (f32x4){0.f, 0.f, 0.f, 0.f};
#pragma unroll
        for (int sp = 0; sp < 5; ++sp) {
            union { u32x4 u; bf16x8 v; } pb; pb.u.x = pk2(s[2 * sp][0], s[2 * sp][1]); pb.u.y = pk2(s[2 * sp][2], s[2 * sp][3]); pb.u.z = pk2(s[2 * sp + 1][0], s[2 * sp + 1][1]); pb.u.w = pk2(s[2 * sp + 1][2], s[2 * sp + 1][3]);
#pragma unroll
            for (int dt = 0; dt < 4; ++dt) { const LAS unsigned char* vp = sVT + (dt * 16 + fr) * 552 + (16 * (wave + 2 * sp) + fq * 4) * 2;
                const u32x2 lo = *(const LAS u32x2*)(vp), hi = *(const LAS u32x2*)(vp + 32);
                union { u32x4 u; bf16x8 v; } va; va.u.x = lo.x; va.u.y = lo.y; va.u.z = hi.x; va.u.w = hi.y;
                o[dt] = MFMA16(va.v, pb.v, o[dt]); } }
        const float inv = 1.0f / lsum;
#pragma unroll
        for (int dt = 0; dt < 4; ++dt) { u32x2 w; w.x = pk2(o[dt][0] * inv, o[dt][1] * inv); w.y = pk2(o[dt][2] * inv, o[dt][3] * inv);
            *(u32x2*)(qrow + dt * 16 + fq * 4) = w; }
        if (fq == 0) LSE[((size_t)g * TOK + qtok) * 8 + h] = mx + __logf(lsum);
    }
}

__device__ __forceinline__ void combine_phase(const bf16_t* __restrict__ Qo, const float* __restrict__ LSE, bf16_t* __restrict__ ATT,
                                              bf16_t* OF, const bf16_t* __restrict__ OB, const bf16_t* __restrict__ SHG, const float* __restrict__ ng, int tid) {
    const int gt = blockIdx.x * 512 + tid, gs = gridDim.x * 512;
    for (int idx = gt; idx < TOK * 64; idx += gs) { const int tok = idx >> 6, ch = idx & 63, h = ch >> 3;
        const float l0 = LSE[((size_t)0 * TOK + tok) * 8 + h], l1 = LSE[((size_t)1 * TOK + tok) * 8 + h], l2 = LSE[((size_t)2 * TOK + tok) * 8 + h];
        const float mx = fmaxf(l0, fmaxf(l1, l2)); float e0 = __expf(l0 - mx), e1 = __expf(l1 - mx), e2 = __expf(l2 - mx); const float inv = 1.0f / (e0 + e1 + e2); e0 *= inv; e1 *= inv; e2 *= inv;
        const bf16_t* p = Qo + (size_t)tok * 1536 + ch * 8;
        f32x4 a0, a1, b0, b1, c0, c1; unpack8(*(const u32x4*)(p), a0, a1); unpack8(*(const u32x4*)(p + 512), b0, b1); unpack8(*(const u32x4*)(p + 1024), c0, c1);
        *(u32x4*)(ATT + (size_t)tok * 512 + ch * 8) = pack8(a0 * e0 + b0 * e1 + c0 * e2, a1 * e0 + b1 * e1 + c1 * e2); }
    for (int idx = gt; idx < TOK * 128; idx += gs) { const int tok = idx >> 7, col = (idx & 127) * 8; const size_t off = (size_t)tok * 1024 + col;
        f32x4 a0, a1, b0, b1, s0, s1; unpack8(*(const u32x4*)(OF + off), a0, a1); unpack8(*(const u32x4*)(OB + off), b0, b1); unpack8(*(const u32x4*)(SHG + off), s0, s1);
        a0 = a0 + b0; a1 = a1 + b1;
        float ss = (a0[0] * a0[0] + a0[1] * a0[1]) + (a0[2] * a0[2] + a0[3] * a0[3]) + (a1[0] * a1[0] + a1[1] * a1[1]) + (a1[2] * a1[2] + a1[3] * a1[3]);
        ss += __shfl_xor(ss, 1); ss += __shfl_xor(ss, 2); ss += __shfl_xor(ss, 4); ss += __shfl_xor(ss, 8);
        const float rs = 1.0f / sqrtf(ss * (1.0f / 128.0f) + RMS_EPS);
        const f32x4 g0 = *(const f32x4*)(ng + (col & 127)), g1 = *(const f32x4*)(ng + (col & 127) + 4);
        *(u32x4*)(OF + off) = pack8(a0 * rs * g0 * s0, a1 * rs * g1 * s1); }
}

struct Args { const float* in[15]; float* out; unsigned char* ws; int lo, hi; };
__global__ void __launch_bounds__(512, 2) mk_fwd(Args a) {
    extern __shared__ __attribute__((aligned(16))) unsigned char lds_raw[];
    LAS unsigned char* lds = (LAS unsigned char*)lds_raw;
    cg::grid_group grid = cg::this_grid();
    const int tid = threadIdx.x, lane = tid & 63, wave = __builtin_amdgcn_readfirstlane(tid >> 6);
    const int G_ = gridDim.x, c_ = blockIdx.x;
    const float* x = a.in[0]; const float* ln_in_g = a.in[1]; const float* ln_in_b = a.in[2]; const float* w_in = a.in[3]; const float* hgrn_lb = a.in[4]; const float* hgrn_ng = a.in[5];
    const float* w_att = a.in[6]; const float* w_hg = a.in[7]; const float* w_o = a.in[8]; const float* ln1_g = a.in[9]; const float* ln1_b = a.in[10];
    const float* w_f1 = a.in[11]; const float* w_f2 = a.in[12]; const float* ln2_g = a.in[13]; const float* ln2_b = a.in[14];
    unsigned char* ws = a.ws;
    f32x2* STATS = (f32x2*)(ws + WS_STATS); float* LSE = (float*)(ws + WS_LSE);
    bf16_t* WT_in = (bf16_t*)(ws + WS_WTIN); bf16_t* WT_a = (bf16_t*)(ws + WS_WTA); bf16_t* WT_r = (bf16_t*)(ws + WS_WTR); bf16_t* WT_o = (bf16_t*)(ws + WS_WTO);
    bf16_t* WT_f1 = (bf16_t*)(ws + WS_WTF1); bf16_t* WT_f2 = (bf16_t*)(ws + WS_WTF2);
    unsigned char* R = ws + WS_R; unsigned char* O = ws + WS_O;
    bf16_t* GH = (bf16_t*)R;
    bf16_t* Qb = (bf16_t*)R; bf16_t* Kb = (bf16_t*)(R + 48 * MiB); bf16_t* Vb = (bf16_t*)(R + 96 * MiB);
    bf16_t* ATT = (bf16_t*)(R + 48 * MiB); bf16_t* M1 = (bf16_t*)R; bf16_t* M2 = (bf16_t*)(R + 64 * MiB); bf16_t* ACT = (bf16_t*)R;
    bf16_t* OFB = (bf16_t*)O; bf16_t* REC = (bf16_t*)O; float* H1F = (float*)O;
    bf16_t* HB = (bf16_t*)a.out; bf16_t* SHG = (bf16_t*)((unsigned char*)a.out + 32 * MiB); bf16_t* H1B = (bf16_t*)a.out;
    const int lo = a.lo, hi = a.hi;
#define IN(k) (lo <= (k) && (k) < hi)
#define SEAM(k) do { if (IN(k) && IN((k) + 1)) { asm volatile("s_waitcnt vmcnt(0) lgkmcnt(0)" ::: "memory"); grid.sync(); __builtin_amdgcn_fence(__ATOMIC_ACQUIRE, "agent"); asm volatile("s_waitcnt vmcnt(0)" ::: "memory"); } } while (0)
    const int gw = c_ * 8 + wave, NGW = G_ * 8;

    if (IN(0)) {
        LAS float* scr = (LAS float*)(lds + wave * 16384);
        constexpr int I0 = 16 * 368, I1 = 8 * 32, I2 = 16 * 32, I3 = 16 * 32, I4 = 16 * 176, I5 = 44 * 32;
        for (int it = gw; it < I0 + I1 + I2 + I3 + I4 + I5; it += NGW) { int r = it;
            if (r < I0) { tr_item(w_in, 11776, (r / 368) * 64, (r % 368) * 32, WT_in, 1024, (r % 368) * 32, scr, lane); continue; } r -= I0;
            if (r < I1) { tr_item(w_att, 1024, (r / 32) * 64, (r % 32) * 32, WT_a, 512, (r % 32) * 32, scr, lane); continue; } r -= I1;
            if (r < I2) { tr_item(w_hg, 1024, (r / 32) * 64, (r % 32) * 32, WT_r, 1024, (r % 32) * 32, scr, lane); continue; } r -= I2;
            if (r < I3) { tr_item(w_o, 1024, (r / 32) * 64, (r % 32) * 32, WT_o, 1024, (r % 32) * 32, scr, lane); continue; } r -= I3;
            if (r < I4) { const int nb = r % 176, r0 = nb * 32; const int pn = r0 >> 8, bj = (r0 >> 7) & 1, j = r0 & 127;
                tr_item(w_f1, 2 * DFF, (r / 176) * 64, bj * DFF + pn * 128 + j, WT_f1, 1024, r0, scr, lane); continue; } r -= I4;
            tr_item(w_f2, 1024, (r / 32) * 64, (r % 32) * 32, WT_f2, DFF, (r % 32) * 32, scr, lane); }
        for (int m = gw; m < TOK; m += NGW) ln_row<false, true, true>(x + (size_t)m * 1024, ln_in_g, ln_in_b, nullptr, HB + (size_t)m * 1024, STATS + m, lane);
    }
    SEAM(0);
    if (IN(1)) {
        pg8::Gemm g{HB, WT_in + (size_t)4608 * 1024, TOK, 5120, 1024}; pg8::StaticOrder S; S.init(TOK, 5120, G_, c_);
        EpiHg E{GH, SHG}; pg8::gemm_phase<EpiHg, pg8::StaticOrder>(lds, g, S, E, nullptr);
    }
    SEAM(1);
    if (IN(2)) hgrn_phase(lds, GH, hgrn_lb, OFB, tid, lane, wave);
    SEAM(2);
    if (IN(3)) {
        pg8::Gemm g{HB, WT_in, TOK, 4608, 1024}; pg8::StaticOrder S; S.init(TOK, 4608, G_, c_);
        EpiQKV E{Qb}; pg8::gemm_phase<EpiQKV, pg8::StaticOrder>(lds, g, S, E, nullptr);
    }
    SEAM(3);
    if (IN(4)) attn_phase(lds, Qb, Kb, Vb, LSE, tid, lane, wave);
    SEAM(4);
    if (IN(5)) combine_phase(Qb, LSE, ATT, OFB, OFB + (size_t)TOK * 1024, SHG, hgrn_ng, tid);
    SEAM(5);
    if (IN(6)) {
        pg8::StaticOrder S; S.init(TOK, 1024, G_, c_);
        { pg8::Gemm g{HB, WT_in + (size_t)9728 * 1024, TOK, 1024, 1024}; EpiMix<0> E{M1, nullptr}; pg8::gemm_phase<EpiMix<0>, pg8::StaticOrder>(lds, g, S, E, nullptr); }
        { pg8::Gemm g{ATT, WT_a, TOK, 1024, 512}; EpiMix<1> E{M1, nullptr}; pg8::gemm_phase<EpiMix<1>, pg8::StaticOrder>(lds, g, S, E, nullptr); }
        { pg8::Gemm g{HB, WT_in + (size_t)10752 * 1024, TOK, 1024, 1024}; EpiMix<0> E{M2, nullptr}; pg8::gemm_phase<EpiMix<0>, pg8::StaticOrder>(lds, g, S, E, nullptr); }
        { pg8::Gemm g{REC, WT_r, TOK, 1024, 1024}; EpiMix<2> E{M1, M2}; pg8::gemm_phase<EpiMix<2>, pg8::StaticOrder>(lds, g, S, E, nullptr); }
    }
    SEAM(6);
    if (IN(7)) {
        pg8::Gemm g{M1, WT_o, TOK, 1024, 1024}; pg8::StaticOrder S; S.init(TOK, 1024, G_, c_);
        EpiWo E{x, STATS, ln_in_g, ln_in_b, H1F}; pg8::gemm_phase<EpiWo, pg8::StaticOrder>(lds, g, S, E, nullptr);
    }
    SEAM(7);
    if (IN(8)) for (int m = gw; m < TOK; m += NGW) ln_row<true, true, false>(H1F + (size_t)m * 1024, ln1_g, ln1_b, H1F + (size_t)m * 1024, H1B + (size_t)m * 1024, nullptr, lane);
    SEAM(8);
    if (IN(9)) {
        pg8::Gemm g{H1B, WT_f1, TOK, 2 * DFF, 1024}; pg8::StaticOrder S; S.init(TOK, 2 * DFF, G_, c_);
        EpiFfnIn E{ACT}; pg8::gemm_phase<EpiFfnIn, pg8::StaticOrder>(lds, g, S, E, nullptr);
    }
    SEAM(9);
    if (IN(10)) {
        pg8::Gemm g{ACT, WT_f2, TOK, 1024, DFF}; pg8::StaticOrder S; S.init(TOK, 1024, G_, c_);
        EpiFfnOut E{H1F, a.out}; pg8::gemm_phase<EpiFfnOut, pg8::StaticOrder>(lds, g, S, E, nullptr);
    }
    SEAM(10);
    if (IN(11)) for (int m = gw; m < TOK; m += NGW) ln_row<true, false, false>(a.out + (size_t)m * 1024, ln2_g, ln2_b, a.out + (size_t)m * 1024, nullptr, nullptr, lane);
#undef IN
#undef SEAM
}

#ifndef MK_MULTI
#define MK_MULTI 0
#endif
extern "C" void kernel_launch(void* const* d_in, const int* in_sizes, int n_in, void* d_out, int out_size, void* d_ws, size_t ws_size, hipStream_t stream) {
    static int grid = 0;
    if (grid == 0) {
        int dev = 0, cus = 0, per_cu = 0;
        (void)hipGetDevice(&dev); (void)hipDeviceGetAttribute(&cus, hipDeviceAttributeMultiprocessorCount, dev);
        (void)hipFuncSetAttribute((const void*)mk_fwd, hipFuncAttributeMaxDynamicSharedMemorySize, LDS_BYTES);
        (void)hipOccupancyMaxActiveBlocksPerMultiprocessor(&per_cu, (const void*)mk_fwd, 512, LDS_BYTES);
        if (per_cu < 1) { fprintf(stderr, "kernel_launch: occupancy query says %d blocks per CU\n", per_cu); per_cu = 1; }
        grid = cus * 1;
        if (ws_size < 256 * MiB) fprintf(stderr, "kernel_launch: workspace too small (%zu)\n", ws_size);
    }
    Args a{};
    for (int i = 0; i < 15; ++i) a.in[i] = (const float*)d_in[i];
    a.out = (float*)d_out; a.ws = (unsigned char*)d_ws;
#if MK_MULTI
    for (int p = 0; p < NPHASE; ++p) { a.lo = p; a.hi = p + 1; hipLaunchKernelGGL(mk_fwd, dim3(grid), dim3(512), LDS_BYTES, stream, a); }
#else
    a.lo = 0; a.hi = NPHASE;
    void* args[] = {&a};
    hipError_t e = hipLaunchCooperativeKernel((const void*)mk_fwd, dim3(grid), dim3(512), args, LDS_BYTES, stream);
    if (e != hipSuccess) fprintf(stderr, "cooperative launch failed: %s (grid %d)\n", hipGetErrorString(e), grid);
#endif
}
```

```cpp
#include <hip/hip_runtime.h>
#include <hip/hip_cooperative_groups.h>
#include <cstdio>
namespace cg = cooperative_groups;
namespace pg8 {
#define PG8_LAS __attribute__((address_space(3)))
typedef unsigned short bf16_t;
typedef short bf16x8 __attribute__((ext_vector_type(8)));
typedef float f32x4 __attribute__((ext_vector_type(4)));
typedef unsigned u32x4 __attribute__((ext_vector_type(4)));
constexpr int BM = 256, BK = 64, HALF = 128, HTB = HALF * BK * 2  , STAGE_BYTES = 8 * HTB, NXCD = 8, WGM = 8;

__host__ __device__ __forceinline__ int lds_byte(int r, int c) { const int st = (r >> 4) * 2 + (c >> 5), rr = r & 15, cc = c & 31, ob = rr * 64 + cc * 2; return st * 1024 + (ob ^ (((ob >> 9) & 1) << 5)); }
__host__ __device__ __forceinline__ void stage_rc(int b, int& R, int& C) { const int st = b / 1024, sb = b % 1024, swz = sb ^ (((sb >> 9) & 1) << 5); R = (st >> 1) * 16 + swz / 64; C = (st & 1) * 32 + (swz % 64) / 2; }
__host__ __device__ __forceinline__ int perm32(int rho) { const int n = rho >> 4, i = rho & 15; return 8 * (i >> 2) + 4 * n + (i & 3); }

struct Unit { int pm, pn; };
struct Gemm { const bf16_t* A; const bf16_t* Bt; int M, N, K; };

struct StaticOrder {
    int nM, nN, nwg, G, c;
    __host__ __device__ void init(int M, int N, int G_, int c_) { nM = M / BM; nN = N / BM; nwg = nM * nN; G = G_; c = c_; }
    __host__ __device__ bool next(int i, Unit& u) const {
        const long L = (long)i * G + c; if (L >= nwg) return false;
        int wgid = (int)L; { const int q = nwg / NXCD, r = nwg % NXCD, xcd = wgid % NXCD, off = wgid / NXCD; wgid = (xcd < r ? xcd * (q + 1) : r * (q + 1) + (xcd - r) * q) + off; }
        const int nig = WGM * nN, gid = wgid / nig, fm = gid * WGM, gsz = (nM - fm) < WGM ? (nM - fm) : WGM;
        u.pm = fm + ((wgid % nig) % gsz); u.pn = (wgid % nig) / gsz; return true;
    }
    __device__ __forceinline__ void a_ready(const Unit&) const {}
    __device__ __forceinline__ void done(const Unit&) const {}
};
__device__ __forceinline__ unsigned cvt_pk_bf16(float lo, float hi) { unsigned r; asm volatile("v_cvt_pk_bf16_f32 %0, %1, %2" : "=v"(r) : "v"(lo), "v"(hi)); return r; }
typedef float f32x2 __attribute__((ext_vector_type(2)));
template <class Epi, class Sched, bool STAMP = false>
__device__ __forceinline__ void gemm_phase(PG8_LAS unsigned char* lds, const Gemm g, const Sched& S, const Epi& E, unsigned long long* stamps) {
    const int tid = threadIdx.x, wid = __builtin_amdgcn_readfirstlane(tid >> 6), lane = tid & 63, wr = wid >> 2, wc = wid & 3, fr = lane & 15, fq = lane >> 4;
    const int K = g.K, nt = K / BK;
    int ts_lo = 0, ts_hi = 0, nts = 0; const unsigned long long rt_entry = STAMP ? (unsigned long long)wall_clock64() : 0ull;
#define PG8_STAMP() do { if (STAMP && wid == 0 && nts < 64) { const unsigned long long _c = (unsigned long long)clock64(); \
        ts_lo = (lane == nts) ? (int)(unsigned)_c : ts_lo; ts_hi = (lane == nts) ? (int)(unsigned)(_c >> 32) : ts_hi; ++nts; } } while (0)
    PG8_STAMP();
    unsigned voffA[2], voffB[2];
#pragma unroll
    for (int i = 0; i < 2; ++i) { int R, C; stage_rc(tid * 16 + i * 8192, R, C); const int Rb = Epi::PERM ? ((R & ~31) + perm32(R & 31)) : R;
        voffA[i] = (unsigned)(R * K + C) * 2u; voffB[i] = (unsigned)(Rb * K + C) * 2u; }
    const size_t kstep = (size_t)(BK * 2);
    const size_t hstep = (size_t)HALF * K * 2;
    const size_t tstep = 2 * hstep;
    const unsigned ldsw = (unsigned)wid * 1024u;
    const int aoff = lds_byte(wr * 64 + fr, fq * 8), boff = lds_byte(wc * 32 + fr, fq * 8);
#define PG8_SA(b, h) (((b) * 2 + (h)) * HTB)
#define PG8_SB(b, h) ((4 + (b) * 2 + (h)) * HTB)
#define PG8_STAGE(bufoff, gbase, voff) do { _Pragma("unroll") for (int _i = 0; _i < 2; ++_i) \
        __builtin_amdgcn_global_load_lds((const unsigned*)((const char*)(gbase) + (voff)[_i]), (PG8_LAS unsigned*)(lds + (bufoff) + ldsw + _i * 8192), 16, 0, 0); } while (0)
#define PG8_LDA(dst, b, h) do { _Pragma("unroll") for (int m = 0; m < 4; ++m) _Pragma("unroll") for (int k = 0; k < 2; ++k) dst[m][k] = *(const PG8_LAS bf16x8*)(lds + PG8_SA(b, h) + aoff + m * 2048 + k * 1024); } while (0)
#define PG8_LDB(dst, b, h) do { _Pragma("unroll") for (int n = 0; n < 2; ++n) _Pragma("unroll") for (int k = 0; k < 2; ++k) dst[n][k] = *(const PG8_LAS bf16x8*)(lds + PG8_SB(b, h) + boff + n * 2048 + k * 1024); } while (0)
#define PG8_MMA(ai, bj, At, Bt) do { __builtin_amdgcn_s_setprio(1); _Pragma("unroll") for (int m = 0; m < 4; ++m) _Pragma("unroll") for (int n = 0; n < 2; ++n) _Pragma("unroll") for (int k = 0; k < 2; ++k) \
        acc[ai][bj][m][n] = __builtin_amdgcn_mfma_f32_16x16x32_bf16(Bt[n][k], At[m][k], acc[ai][bj][m][n], 0, 0, 0); __builtin_amdgcn_s_setprio(0); } while (0)
#define PG8_WAIT_V(n) asm volatile("s_waitcnt vmcnt(" #n ")" ::: "memory")
#define PG8_WAIT_L(n) asm volatile("s_waitcnt lgkmcnt(" #n ")" ::: "memory")
#define PG8_BAR __builtin_amdgcn_s_barrier()
#define PG8_SCHED __builtin_amdgcn_sched_barrier(0)
    Unit cur, nxt; int ui = 0;
    if (!S.next(0, cur)) return;
    f32x4 acc[2][2][4][2];
#pragma unroll
    for (int a = 0; a < 2; ++a)
#pragma unroll
        for (int b = 0; b < 2; ++b)
#pragma unroll
            for (int m = 0; m < 4; ++m)
#pragma unroll
                for (int n = 0; n < 2; ++n) acc[a][b][m][n] = (f32x4){0.f, 0.f, 0.f, 0.f};
    bf16x8 At[4][2], B0[2][2], B1[2][2];
    const char* cA = (const char*)g.A + (size_t)cur.pm * tstep; const char* cB = (const char*)g.Bt + (size_t)cur.pn * tstep;
    S.a_ready(cur);
    PG8_STAGE(PG8_SB(0, 0), cB, voffB); PG8_STAGE(PG8_SA(0, 0), cA, voffA); PG8_STAGE(PG8_SB(0, 1), cB + hstep, voffB); PG8_STAGE(PG8_SA(0, 1), cA + hstep, voffA);
    if (wr == 1) PG8_BAR;
    PG8_WAIT_V(4); PG8_BAR;
    PG8_STAGE(PG8_SB(1, 0), cB + kstep, voffB); PG8_STAGE(PG8_SA(1, 0), cA + kstep, voffA); PG8_STAGE(PG8_SB(1, 1), cB + hstep + kstep, voffB);
    PG8_WAIT_V(6); PG8_BAR;
    PG8_STAMP();
    for (;;) {
        const bool has_next = S.next(ui + 1, nxt);
        const char* nA = has_next ? (const char*)g.A + (size_t)nxt.pm * tstep : cA; const char* nB = has_next ? (const char*)g.Bt + (size_t)nxt.pn * tstep : cB;
        for (int t = 0; t < nt; t += 2) {
            const bool last = (t == nt - 2);
            const char* a1 = cA + (size_t)(t + 1) * kstep;
            const char* a2 = last ? nA : cA + (size_t)(t + 2) * kstep; const char* b2 = last ? nB : cB + (size_t)(t + 2) * kstep;
            const char* a3 = a2 + kstep; const char* b3 = b2 + kstep;
            if (last && has_next) S.a_ready(nxt);
            PG8_LDB(B0, 0, 0); PG8_SCHED; PG8_LDA(At, 0, 0); PG8_STAGE(PG8_SA(1, 1), a1 + hstep, voffA);
            PG8_WAIT_L(8); PG8_BAR; PG8_WAIT_L(0); PG8_MMA(0, 0, At, B0); PG8_BAR; PG8_SCHED;
            PG8_LDB(B1, 0, 1); PG8_STAGE(PG8_SB(0, 0), b2, voffB);
            PG8_BAR; PG8_WAIT_L(0); PG8_MMA(0, 1, At, B1); PG8_BAR;
            PG8_LDA(At, 0, 1); PG8_STAGE(PG8_SA(0, 0), a2, voffA);
            PG8_BAR; PG8_WAIT_L(0); PG8_MMA(1, 0, At, B0); PG8_BAR; PG8_SCHED;
            PG8_STAGE(PG8_SB(0, 1), b2 + hstep, voffB);
            PG8_WAIT_V(6); PG8_BAR; PG8_MMA(1, 1, At, B1); PG8_BAR;
            PG8_LDB(B0, 1, 0); PG8_SCHED; PG8_LDA(At, 1, 0); PG8_STAGE(PG8_SA(0, 1), a2 + hstep, voffA);
            PG8_WAIT_L(8); PG8_BAR; PG8_WAIT_L(0); PG8_MMA(0, 0, At, B0); PG8_BAR; PG8_SCHED;
            PG8_LDB(B1, 1, 1); PG8_STAGE(PG8_SB(1, 0), b3, voffB);
            PG8_BAR; PG8_WAIT_L(0); PG8_MMA(0, 1, At, B1); PG8_BAR;
            PG8_LDA(At, 1, 1); PG8_STAGE(PG8_SA(1, 0), a3, voffA);
            PG8_BAR; PG8_WAIT_L(0); PG8_MMA(1, 0, At, B0); PG8_BAR; PG8_SCHED;
            PG8_STAGE(PG8_SB(1, 1), b3 + hstep, voffB);
            PG8_WAIT_V(6); PG8_BAR; PG8_MMA(1, 1, At, B1); PG8_BAR;
        }
        PG8_STAMP();
        if constexpr (!Epi::AFTER_DRAIN) { E(acc, cur, wr, wc, fr, fq); S.done(cur); }
        PG8_STAMP();
        if (!has_next) break;
#pragma unroll
        for (int a = 0; a < 2; ++a)
#pragma unroll
            for (int b = 0; b < 2; ++b)
#pragma unroll
                for (int m = 0; m < 4; ++m)
#pragma unroll
                    for (int n = 0; n < 2; ++n) acc[a][b][m][n] = (f32x4){0.f, 0.f, 0.f, 0.f};
        cur = nxt; cA = nA; cB = nB; ++ui;
    }
    PG8_WAIT_V(0);
    if (wr == 0) PG8_BAR;
    PG8_BAR;
    if constexpr (Epi::AFTER_DRAIN) { E.fused(acc, cur, wr, wc, fr, fq, lds, wid, lane); S.done(cur); }
    PG8_STAMP();
    if (STAMP && wid == 0) { stamps[lane] = lane < nts ? (((unsigned long long)(unsigned)ts_hi << 32) | (unsigned)ts_lo) : 0ull;
        if (lane == 62) stamps[62] = rt_entry; if (lane == 63) stamps[63] = (unsigned long long)wall_clock64(); }
#undef PG8_STAMP
#undef PG8_SA
#undef PG8_SB
#undef PG8_STAGE
#undef PG8_LDA
#undef PG8_LDB
#undef PG8_MMA
#undef PG8_WAIT_V
#undef PG8_WAIT_L
#undef PG8_BAR
#undef PG8_SCHED
}
}
using pg8::bf16_t; using pg8::bf16x8; using pg8::f32x4; using pg8::u32x4; using pg8::Unit;
#define LAS __attribute__((address_space(3)))
typedef float f32x2 __attribute__((ext_vector_type(2)));
typedef unsigned u32x2 __attribute__((ext_vector_type(2)));

constexpr int TOK = 16384, DM = 1024, SEQ = 4096, DFF = 2816;
constexpr float ALPHA = 1.189207115002721f;
constexpr float LN_EPS = 1e-5f, RMS_EPS = 1e-6f;
constexpr size_t MiB = (size_t)1 << 20;
constexpr size_t WS_STATS = 0, WS_LSE = 1 * MiB, WS_WTIN = 3 * MiB, WS_WTA = 26 * MiB, WS_WTR = 27 * MiB, WS_WTO = 29 * MiB,
                 WS_WTF1 = 31 * MiB, WS_WTF2 = 42 * MiB, WS_R = 48 * MiB, WS_O = 192 * MiB;
constexpr int LDS_BYTES = 147456;
constexpr size_t WS_BAR = 2 * MiB + 512 * 1024;
constexpr int NPHASE = 12;

typedef float f32x2_t __attribute__((ext_vector_type(2)));
typedef __bf16 bf16v2_t __attribute__((ext_vector_type(2)));
__device__ __forceinline__ unsigned pk2(float lo, float hi) { f32x2_t v = {lo, hi}; bf16v2_t b = __builtin_convertvector(v, bf16v2_t); return __builtin_bit_cast(unsigned, b); }
__device__ __forceinline__ unsigned short f2bf(float f) { return (unsigned short)(pk2(f, 0.f) & 0xffffu); }
__device__ __forceinline__ float bf2f(unsigned short b) { return __uint_as_float(((unsigned)b) << 16); }
__device__ __forceinline__ float bflo(unsigned w) { return __uint_as_float(w << 16); }
__device__ __forceinline__ float bfhi(unsigned w) { return __uint_as_float(w & 0xffff0000u); }
__device__ __forceinline__ float sigmoidf_(float x) { return 1.0f / (1.0f + __expf(-x)); }
__device__ __forceinline__ float siluf_(float x) { return x / (1.0f + __expf(-x)); }
__device__ __forceinline__ float wave_sum(float v) {
#pragma unroll
    for (int o = 1; o < 64; o <<= 1) v += __shfl_xor(v, o);
    return v;
}
#define LDS_WAIT() asm volatile("s_waitcnt lgkmcnt(0)" ::: "memory")

__device__ __forceinline__ u32x4 pack8(const f32x4& a, const f32x4& b) { u32x4 w; w.x = pk2(a[0], a[1]); w.y = pk2(a[2], a[3]); w.z = pk2(b[0], b[1]); w.w = pk2(b[2], b[3]); return w; }
__device__ __forceinline__ void unpack8(const u32x4& w, f32x4& a, f32x4& b) { a[0] = bflo(w.x); a[1] = bfhi(w.x); a[2] = bflo(w.y); a[3] = bfhi(w.y); b[0] = bflo(w.z); b[1] = bfhi(w.z); b[2] = bflo(w.w); b[3] = bfhi(w.w); }

struct EpiHg {
    static constexpr bool PERM = true, AFTER_DRAIN = false;
    bf16_t* G; bf16_t* SHG;
    __device__ __forceinline__ void operator()(const f32x4 (&acc)[2][2][4][2], const Unit& u, int wr, int wc, int fr, int fq) const {
        const int sec = u.pn >> 2;
        bf16_t* base = sec < 4 ? G : SHG; const int ld = sec < 4 ? 4096 : 1024; const int colt = sec < 4 ? u.pn * 256 : (u.pn - 16) * 256;
        const int row0 = u.pm * 256 + wr * 64 + fr, col0 = colt + wc * 32 + 8 * fq;
#pragma unroll
        for (int ai = 0; ai < 2; ++ai)
#pragma unroll
            for (int m = 0; m < 4; ++m) { bf16_t* rowp = base + (size_t)(row0 + ai * 128 + m * 16) * ld + col0;
#pragma unroll
                for (int bj = 0; bj < 2; ++bj) { f32x4 v0 = acc[ai][bj][m][0], v1 = acc[ai][bj][m][1];
                    if (sec == 0) {
#pragma unroll
                        for (int j = 0; j < 4; ++j) { v0[j] = siluf_(v0[j]) * 0.08838834764831845f; v1[j] = siluf_(v1[j]) * 0.08838834764831845f; } }
                    else if (sec == 4) {
#pragma unroll
                        for (int j = 0; j < 4; ++j) { v0[j] = siluf_(v0[j]); v1[j] = siluf_(v1[j]); } }
                    *(u32x4*)(rowp + bj * 128) = pack8(v0, v1); } }
    }
};
struct EpiQKV {
    static constexpr bool PERM = true, AFTER_DRAIN = false;
    bf16_t* QKV;
    __device__ __forceinline__ void operator()(const f32x4 (&acc)[2][2][4][2], const Unit& u, int wr, int wc, int fr, int fq) const {
        const int t = u.pn / 6; const int colt = (u.pn - 6 * t) * 256; const float sc = t == 0 ? 0.125f : 1.0f;
        bf16_t* base = QKV + (size_t)t * TOK * 1536;
        const int row0 = u.pm * 256 + wr * 64 + fr, col0 = colt + wc * 32 + 8 * fq;
#pragma unroll
        for (int ai = 0; ai < 2; ++ai)
#pragma unroll
            for (int m = 0; m < 4; ++m) { bf16_t* rowp = base + (size_t)(row0 + ai * 128 + m * 16) * 1536 + col0;
#pragma unroll
                for (int bj = 0; bj < 2; ++bj) *(u32x4*)(rowp + bj * 128) = pack8(acc[ai][bj][m][0] * sc, acc[ai][bj][m][1] * sc); }
    }
};
template <int MODE> struct EpiMix {
    static constexpr bool PERM = true, AFTER_DRAIN = false;
    bf16_t* O; const bf16_t* G2;
    __device__ __forceinline__ void operator()(const f32x4 (&acc)[2][2][4][2], const Unit& u, int wr, int wc, int fr, int fq) const {
        const int row0 = u.pm * 256 + wr * 64 + fr, col0 = u.pn * 256 + wc * 32 + 8 * fq;
#pragma unroll
        for (int ai = 0; ai < 2; ++ai)
#pragma unroll
            for (int m = 0; m < 4; ++m) { const size_t off = (size_t)(row0 + ai * 128 + m * 16) * 1024 + col0;
#pragma unroll
                for (int bj = 0; bj < 2; ++bj) { f32x4 v0 = acc[ai][bj][m][0], v1 = acc[ai][bj][m][1];
                    if (MODE == 0) {
#pragma unroll
                        for (int j = 0; j < 4; ++j) { v0[j] = sigmoidf_(v0[j]); v1[j] = sigmoidf_(v1[j]); } }
                    if (MODE == 1) { f32x4 p0, p1; unpack8(*(const u32x4*)(O + off + bj * 128), p0, p1); v0 = p0 * v0; v1 = p1 * v1; }
                    if (MODE == 2) { f32x4 p0, p1, g0, g1; unpack8(*(const u32x4*)(O + off + bj * 128), p0, p1); unpack8(*(const u32x4*)(G2 + off + bj * 128), g0, g1); v0 = p0 + g0 * v0; v1 = p1 + g1 * v1; }
                    *(u32x4*)(O + off + bj * 128) = pack8(v0, v1); } }
    }
};
struct EpiWo {
    static constexpr bool PERM = false, AFTER_DRAIN = false;
    const float* x; const f32x2* stats; const float* g; const float* b; float* Y;
    __device__ __forceinline__ void operator()(const f32x4 (&acc)[2][2][4][2], const Unit& u, int wr, int wc, int fr, int fq) const {
        const int row0 = u.pm * 256 + wr * 64 + fr, col0 = u.pn * 256 + wc * 32 + 4 * fq;
        f32x4 gv[2][2], bv[2][2];
#pragma unroll
        for (int bj = 0; bj < 2; ++bj)
#pragma unroll
            for (int n = 0; n < 2; ++n) { gv[bj][n] = *(const f32x4*)(g + col0 + bj * 128 + n * 16) * ALPHA; bv[bj][n] = *(const f32x4*)(b + col0 + bj * 128 + n * 16) * ALPHA; }
#pragma unroll
        for (int ai = 0; ai < 2; ++ai)
#pragma unroll
            for (int m = 0; m < 4; ++m) { const int row = row0 + ai * 128 + m * 16; const f32x2 st = stats[row]; const size_t off = (size_t)row * 1024 + col0;
#pragma unroll
                for (int bj = 0; bj < 2; ++bj)
#pragma unroll
                    for (int n = 0; n < 2; ++n) { const f32x4 xv = *(const f32x4*)(x + off + bj * 128 + n * 16);
                        *(f32x4*)(Y + off + bj * 128 + n * 16) = (xv - st.x) * st.y * gv[bj][n] + bv[bj][n] + acc[ai][bj][m][n]; }
                asm volatile("" ::: "memory"); }
    }
};
struct EpiFfnIn {
    static constexpr bool PERM = true, AFTER_DRAIN = false;
    bf16_t* ACT;
    __device__ __forceinline__ void operator()(const f32x4 (&acc)[2][2][4][2], const Unit& u, int wr, int wc, int fr, int fq) const {
        const int row0 = u.pm * 256 + wr * 64 + fr, col0 = u.pn * 128 + wc * 32 + 8 * fq;
#pragma unroll
        for (int ai = 0; ai < 2; ++ai)
#pragma unroll
            for (int m = 0; m < 4; ++m) { f32x4 v0, v1;
#pragma unroll
                for (int j = 0; j < 4; ++j) { v0[j] = siluf_(acc[ai][0][m][0][j]) * acc[ai][1][m][0][j]; v1[j] = siluf_(acc[ai][0][m][1][j]) * acc[ai][1][m][1][j]; }
                *(u32x4*)(ACT + (size_t)(row0 + ai * 128 + m * 16) * DFF + col0) = pack8(v0, v1); }
    }
};
struct EpiFfnOut {
    static constexpr bool PERM = false, AFTER_DRAIN = false;
    const float* H1; float* Y;
    __device__ __forceinline__ void operator()(const f32x4 (&acc)[2][2][4][2], const Unit& u, int wr, int wc, int fr, int fq) const {
        const int row0 = u.pm * 256 + wr * 64 + fr, col0 = u.pn * 256 + wc * 32 + 4 * fq;
#pragma unroll
        for (int ai = 0; ai < 2; ++ai)
#pragma unroll
            for (int m = 0; m < 4; ++m) { const size_t off = (size_t)(row0 + ai * 128 + m * 16) * 1024 + col0;
#pragma unroll
                for (int bj = 0; bj < 2; ++bj)
#pragma unroll
                    for (int n = 0; n < 2; ++n) { const f32x4 hv = *(const f32x4*)(H1 + off + bj * 128 + n * 16);
                        *(f32x4*)(Y + off + bj * 128 + n * 16) = hv * ALPHA + acc[ai][bj][m][n]; }
                asm volatile("" ::: "memory"); }
    }
};

__device__ __forceinline__ void tr_item(const float* __restrict__ W, int ldw, int k0, int c0, bf16_t* WT, int K, int r0, LAS float* scr, int lane) {
#pragma unroll 8
    for (int i = 0; i < 32; ++i) { const int kk = 2 * i + (lane >> 5); scr[kk * 33 + (lane & 31)] = W[(size_t)(k0 + kk) * ldw + c0 + (lane & 31)]; }
    LDS_WAIT();
    const int c = lane & 7;
#pragma unroll
    for (int j = 0; j < 4; ++j) { const int n = (lane >> 3) + 8 * j; const LAS float* s = scr + (8 * c) * 33 + n;
        u32x4 o; o.x = pk2(s[0 * 33], s[1 * 33]); o.y = pk2(s[2 * 33], s[3 * 33]); o.z = pk2(s[4 * 33], s[5 * 33]); o.w = pk2(s[6 * 33], s[7 * 33]);
        *(u32x4*)(WT + (size_t)(r0 + n) * K + k0 + 8 * c) = o; }
    LDS_WAIT();
}
template <bool WF32, bool WBF16, bool WSTATS>
__device__ __forceinline__ void ln_row(const float* in, const float* g, const float* b, float* outf, bf16_t* outb, f32x2* stat, int lane) {
    const f32x4* xr = (const f32x4*)in + lane;
    f32x4 v[4]; float s = 0.f;
#pragma unroll
    for (int j = 0; j < 4; ++j) { v[j] = xr[64 * j]; s += (v[j][0] + v[j][1]) + (v[j][2] + v[j][3]); }
    const float mean = wave_sum(s) * (1.f / 1024.f); float s2 = 0.f;
#pragma unroll
    for (int j = 0; j < 4; ++j) { v[j] = v[j] - mean; s2 += (v[j][0] * v[j][0] + v[j][1] * v[j][1]) + (v[j][2] * v[j][2] + v[j][3] * v[j][3]); }
    const float rstd = 1.0f / sqrtf(wave_sum(s2) * (1.f / 1024.f) + LN_EPS);
    if (WSTATS && lane == 0) *stat = (f32x2){mean, rstd};
#pragma unroll
    for (int j = 0; j < 4; ++j) { const f32x4 gv = ((const f32x4*)g)[lane + 64 * j], bv = ((const f32x4*)b)[lane + 64 * j];
        const f32x4 y = v[j] * rstd * gv + bv;
        if (WF32) ((f32x4*)outf)[lane + 64 * j] = y;
        if (WBF16) { u32x2 w; w.x = pk2(y[0], y[1]); w.y = pk2(y[2], y[3]); ((u32x2*)outb)[lane + 64 * j] = w; } }
}
#define MFMA16(a, b, c) __builtin_amdgcn_mfma_f32_16x16x32_bf16((a), (b), (c), 0, 0, 0)

__device__ __forceinline__ void hgrn_phase(LAS unsigned char* lds, const bf16_t* __restrict__ G, const float* __restrict__ lbraw, bf16_t* __restrict__ OFB, int tid, int lane, int wave) {
    LAS unsigned char* sQ = lds;
    LAS unsigned char* sKi = lds + 17408;
    LAS unsigned char* sKdT = lds + 34816;
    LAS unsigned char* sVT = lds + 53248;
    LAS unsigned char* sA = lds + 57856;
    LAS unsigned char* sST = lds + 67072;
    LAS float* sTot = (LAS float*)(lds + 75776);
    LAS float* sDec = (LAS float*)(lds + 77824);
    const int fr = lane & 15, fq = lane >> 4;
    const int kcol = tid & 127, rg = tid >> 7;
    const int vj = tid >> 3, vc4 = tid & 7;
    for (int it = blockIdx.x; it < 256; it += gridDim.x) {
        const int vs = it & 3, dir = (it >> 2) & 1, h = (it >> 3) & 7, b = it >> 6;
        const float a0 = lbraw[dir * 2048 + h * 128 + kcol], a1 = lbraw[dir * 2048 + 1024 + h * 128 + kcol];
        const float lb = 1.0f / (1.0f + __expf(a1 - a0)), oml = 1.0f - lb;
        const bf16_t* Gb = G + (size_t)b * SEQ * 4096;
        bf16_t* Ob = OFB + (size_t)dir * TOK * 1024 + (size_t)b * SEQ * 1024 + h * 128 + vs * 32;
        const int qoff = h * 128 + kcol, foff = 1024 + dir * 1024 + h * 128 + kcol, voff = 3072 + h * 128 + vs * 32 + vc4 * 4;
        f32x4 Sacc[2]; Sacc[0] = (f32x4){0.f, 0.f, 0.f, 0.f}; Sacc[1] = Sacc[0];
        __syncthreads();
        for (int e = tid; e < 2176; e += 512) ((LAS unsigned*)sST)[e] = 0u;
        unsigned short qn[16], fn[16]; u32x2 vn;
        {
#pragma unroll
            for (int ii = 0; ii < 16; ++ii) { const int i = rg * 16 + ii; const int t = dir ? (SEQ - 1 - i) : i; qn[ii] = Gb[(size_t)t * 4096 + qoff]; fn[ii] = Gb[(size_t)t * 4096 + foff]; }
            const int t = dir ? (SEQ - 1 - vj) : vj; vn = *(const u32x2*)(Gb + (size_t)t * 4096 + voff);
        }
        __syncthreads();
        for (int n = 0; n < 64; ++n) {
            float cum[16], kk[16], qq[16]; float run = 0.f;
#pragma unroll
            for (int ii = 0; ii < 16; ++ii) { const float x = bf2f(fn[ii]); const float e = __expf(-fabsf(x)); const float sa = 1.0f / (1.0f + e), sbm = e * sa; const float sg = x >= 0.f ? sa : sbm, om = x >= 0.f ? sbm : sa;
                const float f = lb + oml * sg; kk[ii] = oml * om; run += __logf(f); cum[ii] = run; qq[ii] = bf2f(qn[ii]); }
            const u32x2 vcur = vn;
            if (n + 1 < 64) {
#pragma unroll
                for (int ii = 0; ii < 16; ++ii) { const int i = (n + 1) * 64 + rg * 16 + ii; const int t = dir ? (SEQ - 1 - i) : i; qn[ii] = Gb[(size_t)t * 4096 + qoff]; fn[ii] = Gb[(size_t)t * 4096 + foff]; }
                const int i = (n + 1) * 64 + vj; const int t = dir ? (SEQ - 1 - i) : i; vn = *(const u32x2*)(Gb + (size_t)t * 4096 + voff);
            }
            sTot[rg * 128 + kcol] = run;
            __syncthreads();
            float off = 0.f, tot = 0.f;
#pragma unroll
            for (int g2 = 0; g2 < 4; ++g2) { const float t = sTot[g2 * 128 + kcol]; tot += t; off += (g2 < rg) ? t : 0.f; }
            float kd[16];
#pragma unroll
            for (int ii = 0; ii < 16; ++ii) { const float c = cum[ii] + off; const int i = rg * 16 + ii;
                *(LAS unsigned short*)(sQ + i * 272 + kcol * 2) = f2bf(qq[ii] * __expf(c));
                *(LAS unsigned short*)(sKi + i * 272 + kcol * 2) = f2bf(kk[ii] * __expf(-c));
                kd[ii] = kk[ii] * __expf(tot - c); }
            { u32x4 w0, w1; w0.x = pk2(kd[0], kd[1]); w0.y = pk2(kd[2], kd[3]); w0.z = pk2(kd[4], kd[5]); w0.w = pk2(kd[6], kd[7]);
              w1.x = pk2(kd[8], kd[9]); w1.y = pk2(kd[10], kd[11]); w1.z = pk2(kd[12], kd[13]); w1.w = pk2(kd[14], kd[15]);
              *(LAS u32x4*)(sKdT + kcol * 144 + rg * 32) = w0; *(LAS u32x4*)(sKdT + kcol * 144 + rg * 32 + 16) = w1; }
            if (rg == 0) sDec[kcol] = __expf(tot);
            { LAS unsigned char* p = sVT + (vc4 * 4) * 144 + vj * 2;
              *(LAS unsigned short*)(p) = (unsigned short)(vcur.x & 0xffffu); *(LAS unsigned short*)(p + 144) = (unsigned short)(vcur.x >> 16);
              *(LAS unsigned short*)(p + 288) = (unsigned short)(vcur.y & 0xffffu); *(LAS unsigned short*)(p + 432) = (unsigned short)(vcur.y >> 16); }
            __syncthreads();
            const int ti = wave >> 1, tv = wave & 1;
#pragma unroll
            for (int t2 = 0; t2 < 2; ++t2) { const int tj = (wave & 1) * 2 + t2;
                f32x4 a = (f32x4){0.f, 0.f, 0.f, 0.f};
                if (tj <= ti) {
#pragma unroll
                    for (int ks = 0; ks < 4; ++ks) { const bf16x8 A = *(const LAS bf16x8*)(sQ + (ti * 16 + fr) * 272 + fq * 16 + ks * 64);
                        const bf16x8 B = *(const LAS bf16x8*)(sKi + (tj * 16 + fr) * 272 + fq * 16 + ks * 64); a = MFMA16(A, B, a); } }
#pragma unroll
                for (int jj = 0; jj < 4; ++jj) { const int i = ti * 16 + fq * 4 + jj, j = tj * 16 + fr;
                    const float val = (j <= i) ? a[jj] : 0.f; *(LAS unsigned short*)(sA + i * 144 + j * 2) = f2bf(val); } }
            f32x4 o = (f32x4){0.f, 0.f, 0.f, 0.f};
#pragma unroll
            for (int ks = 0; ks < 4; ++ks) { const bf16x8 A = *(const LAS bf16x8*)(sQ + (ti * 16 + fr) * 272 + fq * 16 + ks * 64);
                const bf16x8 B = *(const LAS bf16x8*)(sST + (tv * 16 + fr) * 272 + fq * 16 + ks * 64); o = MFMA16(A, B, o); }
            __syncthreads();
#pragma unroll
            for (int ks = 0; ks < 2; ++ks) { const bf16x8 A = *(const LAS bf16x8*)(sA + (ti * 16 + fr) * 144 + fq * 16 + ks * 64);
                const bf16x8 B = *(const LAS bf16x8*)(sVT + (tv * 16 + fr) * 144 + fq * 16 + ks * 64); o = MFMA16(A, B, o); }
#pragma unroll
            for (int jj = 0; jj < 4; ++jj) { const int i = n * 64 + ti * 16 + fq * 4 + jj; const int t = dir ? (SEQ - 1 - i) : i;
                Ob[(size_t)t * 1024 + tv * 16 + fr] = f2bf(o[jj]); }
#pragma unroll
            for (int jj = 0; jj < 4; ++jj) { const float d = sDec[16 * wave + fq * 4 + jj]; Sacc[0][jj] *= d; Sacc[1][jj] *= d; }
#pragma unroll
            for (int ks = 0; ks < 2; ++ks) { const bf16x8 A = *(const LAS bf16x8*)(sKdT + (16 * wave + fr) * 144 + fq * 16 + ks * 64);
#pragma unroll
                for (int t2 = 0; t2 < 2; ++t2) { const bf16x8 B = *(const LAS bf16x8*)(sVT + (t2 * 16 + fr) * 144 + fq * 16 + ks * 64); Sacc[t2] = MFMA16(A, B, Sacc[t2]); } }
#pragma unroll
            for (int t2 = 0; t2 < 2; ++t2) { u32x2 w; w.x = pk2(Sacc[t2][0], Sacc[t2][1]); w.y = pk2(Sacc[t2][2], Sacc[t2][3]);
                *(LAS u32x2*)(sST + (t2 * 16 + fr) * 272 + (16 * wave + fq * 4) * 2) = w; }
            __syncthreads();
        }
    }
}

__device__ __forceinline__ void attn_phase(LAS unsigned char* lds, bf16_t* Q, const bf16_t* __restrict__ K, const bf16_t* __restrict__ V, float* __restrict__ LSE, int tid, int lane, int wave) {
    LAS unsigned char* sK = lds;
    LAS unsigned char* sVT = lds + 39168;
    const int fr = lane & 15, fq = lane >> 4;
    for (int it = blockIdx.x; it < 3072; it += gridDim.x) {
        const int g = it >> 10, rem = it & 1023, b = rem >> 8, h = (rem >> 5) & 7, sb = rem & 31;
        const int dsh = 2 * g, dil = 1 << dsh, m = SEQ >> dsh, spb = 32 >> dsh;
        const int r = sb >> (5 - dsh), q0 = (sb & (spb - 1)) * 128;
        const int colbase = g * 512 + h * 64;
        __syncthreads();
        for (int e = tid; e < 2176; e += 512) { const int j = e >> 3, c = e & 7; const int kx = q0 - 64 + j; const bool valid = kx >= 0 && kx < m;
            const size_t off = (size_t)(b * SEQ + (valid ? kx : 0) * dil + r) * 1536 + colbase + c * 8;
            u32x4 kv = *(const u32x4*)(K + off), vv = *(const u32x4*)(V + off);
            if (!valid) { kv = (u32x4){0u, 0u, 0u, 0u}; vv = kv; }
            *(LAS u32x4*)(sK + j * 144 + c * 16) = kv;
            LAS unsigned char* p = sVT + (c * 8) * 552 + j * 2;
            *(LAS unsigned short*)(p + 0 * 552) = (unsigned short)(vv.x & 0xffffu); *(LAS unsigned short*)(p + 1 * 552) = (unsigned short)(vv.x >> 16);
            *(LAS unsigned short*)(p + 2 * 552) = (unsigned short)(vv.y & 0xffffu); *(LAS unsigned short*)(p + 3 * 552) = (unsigned short)(vv.y >> 16);
            *(LAS unsigned short*)(p + 4 * 552) = (unsigned short)(vv.z & 0xffffu); *(LAS unsigned short*)(p + 5 * 552) = (unsigned short)(vv.z >> 16);
            *(LAS unsigned short*)(p + 6 * 552) = (unsigned short)(vv.w & 0xffffu); *(LAS unsigned short*)(p + 7 * 552) = (unsigned short)(vv.w >> 16); }
        const int qtok = b * SEQ + (q0 + 16 * wave + fr) * dil + r;
        bf16_t* qrow = Q + (size_t)qtok * 1536 + colbase;
        bf16x8 qf[2]; qf[0] = *(const bf16x8*)(qrow + fq * 8); qf[1] = *(const bf16x8*)(qrow + fq * 8 + 32);
        __syncthreads();
        f32x4 s[10];
#pragma unroll
        for (int kt = 0; kt < 10; ++kt) { f32x4 a = (f32x4){0.f, 0.f, 0.f, 0.f};
#pragma unroll
            for (int ks = 0; ks < 2; ++ks) { const bf16x8 A = *(const LAS bf16x8*)(sK + (16 * (wave + kt) + fr) * 144 + fq * 16 + ks * 64); a = MFMA16(A, qf[ks], a); }
            s[kt] = a; }
        const float sd = exp2f(-(float)(g * 8 + h + 1) * (1.0f / 3.0f)) * (float)dil;
        float mx = -1e30f;
#pragma unroll
        for (int kt = 0; kt < 10; ++kt)
#pragma unroll
            for (int jj = 0; jj < 4; ++jj) { const int rel = -64 + 16 * kt + fq * 4 + jj - fr; const int kx = q0 - 64 + 16 * (wave + kt) + fq * 4 + jj;
                const int ar = rel < 0 ? -rel : rel; const bool valid = ar <= 64 && kx >= 0 && kx < m;
                const float v = valid ? s[kt][jj] - sd * (float)ar : -1e30f; s[kt][jj] = v; mx = fmaxf(mx, v); }
        mx = fmaxf(mx, __shfl_xor(mx, 16)); mx = fmaxf(mx, __shfl_xor(mx, 32));
        float lsum = 0.f;
#pragma unroll
        for (int kt = 0; kt < 10; ++kt)
#pragma unroll
            for (int jj = 0; jj < 4; ++jj) { const float p = __expf(s[kt][jj] - mx); s[kt][jj] = p; lsum += p; }
        lsum += __shfl_xor(lsum, 16); lsum += __shfl_xor(lsum, 32);
        f32x4 o[4];
#pragma unroll
        for (int dt = 0; dt < 4; ++dt) o[dt] = (f32x4){0.f, 0.f, 0.f, 0.f};
#pragma unroll
        for (int sp = 0; sp < 5; ++sp) {
            union { u32x4 u; bf16x8 v; } pb; pb.u.x = pk2(s[2 * sp][0], s[2 * sp][1]); pb.u.y = pk2(s[2 * sp][2], s[2 * sp][3]); pb.u.z = pk2(s[2 * sp + 1][0], s[2 * sp + 1][1]); pb.u.w = pk2(s[2 * sp + 1][2], s[2 * sp + 1][3]);
#pragma unroll
            for (int dt = 0; dt < 4; ++dt) { const LAS unsigned char* vp = sVT + (dt * 16 + fr) * 552 + (16 * (wave + 2 * sp) + fq * 4) * 2;
                const u32x2 lo = *(const LAS u32x2*)(vp), hi = *(const LAS u32x2*)(vp + 32);
                union { u32x4 u; bf16x8 v; } va; va.u.x = lo.x; va.u.y = lo.y; va.u.z = hi.x; va.u.w = hi.y;
                o[dt] = MFMA16(va.v, pb.v, o[dt]); } }
        const float inv = 1.0f / lsum;
#pragma unroll
        for (int dt = 0; dt < 4; ++dt) { u32x2 w; w.x = pk2(o[dt][0] * inv, o[dt][1] * inv); w.y = pk2(o[dt][2] * inv, o[dt][3] * inv);
            *(u32x2*)(qrow + dt * 16 + fq * 4) = w; }
        if (fq == 0) LSE[((size_t)g * TOK + qtok) * 8 + h] = mx + __logf(lsum);
    }
}

__device__ __forceinline__ void combine_phase(const bf16_t* __restrict__ Qo, const float* __restrict__ LSE, bf16_t* __restrict__ ATT,
                                              bf16_t* OF, const bf16_t* __restrict__ OB, const bf16_t* __restrict__ SHG, const float* __restrict__ ng, int tid) {
    const int gt = blockIdx.x * 512 + tid, gs = gridDim.x * 512;
    for (int idx = gt; idx < TOK * 64; idx += gs) { const int tok = idx >> 6, ch = idx & 63, h = ch >> 3;
        const float l0 = LSE[((size_t)0 * TOK + tok) * 8 + h], l1 = LSE[((size_t)1 * TOK + tok) * 8 + h], l2 = LSE[((size_t)2 * TOK + tok) * 8 + h];
        const float mx = fmaxf(l0, fmaxf(l1, l2)); float e0 = __expf(l0 - mx), e1 = __expf(l1 - mx), e2 = __expf(l2 - mx); const float inv = 1.0f / (e0 + e1 + e2); e0 *= inv; e1 *= inv; e2 *= inv;
        const bf16_t* p = Qo + (size_t)tok * 1536 + ch * 8;
        f32x4 a0, a1, b0, b1, c0, c1; unpack8(*(const u32x4*)(p), a0, a1); unpack8(*(const u32x4*)(p + 512), b0, b1); unpack8(*(const u32x4*)(p + 1024), c0, c1);
        *(u32x4*)(ATT + (size_t)tok * 512 + ch * 8) = pack8(a0 * e0 + b0 * e1 + c0 * e2, a1 * e0 + b1 * e1 + c1 * e2); }
    for (int idx = gt; idx < TOK * 128; idx += gs) { const int tok = idx >> 7, col = (idx & 127) * 8; const size_t off = (size_t)tok * 1024 + col;
        f32x4 a0, a1, b0, b1, s0, s1; unpack8(*(const u32x4*)(OF + off), a0, a1); unpack8(*(const u32x4*)(OB + off), b0, b1); unpack8(*(const u32x4*)(SHG + off), s0, s1);
        a0 = a0 + b0; a1 = a1 + b1;
        float ss = (a0[0] * a0[0] + a0[1] * a0[1]) + (a0[2] * a0[2] + a0[3] * a0[3]) + (a1[0] * a1[0] + a1[1] * a1[1]) + (a1[2] * a1[2] + a1[3] * a1[3]);
        ss += __shfl_xor(ss, 1); ss += __shfl_xor(ss, 2); ss += __shfl_xor(ss, 4); ss += __shfl_xor(ss, 8);
        const float rs = 1.0f / sqrtf(ss * (1.0f / 128.0f) + RMS_EPS);
        const f32x4 g0 = *(const f32x4*)(ng + (col & 127)), g1 = *(const f32x4*)(ng + (col & 127) + 4);
        *(u32x4*)(OF + off) = pack8(a0 * rs * g0 * s0, a1 * rs * g1 * s1); }
}

#define XB_TMO      128
#define XB_XCNT(j)  (256  + 64 * (j))
#define XB_XSUB(j)  (1280 + 64 * (j))
#define XB_XGEN(j)  (2304 + 64 * (j))
#define XB_TOP      3328
#define XB_TOPGEN   3392
#define XCD_BAR_WORDS 3456
#define XB_SPIN_CAP (1u << 18)

__device__ __forceinline__ unsigned xb_ld(unsigned* p)              { return __hip_atomic_load(p, __ATOMIC_RELAXED, __HIP_MEMORY_SCOPE_AGENT); }
__device__ __forceinline__ unsigned xb_add(unsigned* p, unsigned v) { return __hip_atomic_fetch_add(p, v, __ATOMIC_RELAXED, __HIP_MEMORY_SCOPE_AGENT); }
__device__ __forceinline__ unsigned xb_xcc_id() { return (unsigned)__builtin_amdgcn_s_getreg((3 << 11) | 20) & 0xFu; }
#define XB_SPIN(cond, bar) do { unsigned _sp = 0; while (cond) { __builtin_amdgcn_s_sleep(1); \
    if ((++_sp & 255u) == 0u) { if (xb_ld(&(bar)[XB_TMO])) break; if (_sp > XB_SPIN_CAP) { atomicAdd(&(bar)[XB_TMO], 1u); break; } } } } while (0)

struct XcdBarrier {
    unsigned* bar; unsigned x;
    volatile LAS unsigned* st;
};

__device__ __forceinline__ XcdBarrier xcd_barrier_post(unsigned* bar, volatile LAS unsigned* st) {
    XcdBarrier b; b.bar = bar; b.x = xb_xcc_id(); b.st = st;
    if (threadIdx.x == 0) (void)xb_add(&bar[XB_XCNT(b.x)], 1u);
    return b;
}
__device__ __forceinline__ void xcd_barrier_complete(unsigned* bar, unsigned x, unsigned& nloc, unsigned& nx) {
    const unsigned G = gridDim.x * gridDim.y * gridDim.z;
    unsigned sum, cnt, mine, sp = 0u;
    for (;;) {
        sum = 0u; cnt = 0u; mine = 0u;
#pragma unroll
        for (unsigned j = 0; j < 16; ++j) { const unsigned c = xb_ld(&bar[XB_XCNT(j)]); sum += c; cnt += (c > 0u) ? 1u : 0u; mine = (j == x) ? c : mine; }
        if (sum == G) break;
        __builtin_amdgcn_s_sleep(1);
        if ((++sp & 255u) == 0u) { if (xb_ld(&bar[XB_TMO])) break; if (sp > XB_SPIN_CAP) { atomicAdd(&bar[XB_TMO], 1u); break; } }
    }
    nloc = mine > 0u ? mine : 1u; nx = cnt > 0u ? cnt : 1u;
}

__device__ __forceinline__ void xcd_barrier(const XcdBarrier& b) {
    asm volatile("s_waitcnt vmcnt(0)" ::: "memory");
    __syncthreads();
    if (threadIdx.x == 0) {
        unsigned* bar = b.bar;
        __builtin_amdgcn_s_waitcnt(0);
        unsigned nloc = b.st[0], nx = b.st[1];
        if (nloc == 0u) { xcd_barrier_complete(bar, b.x, nloc, nx); b.st[0] = nloc; b.st[1] = nx; }
        const unsigned old = xb_add(&bar[XB_XSUB(b.x)], 1u);
        const unsigned gen = old / nloc;
        if (old + 1u == (gen + 1u) * nloc) {
            __builtin_amdgcn_fence(__ATOMIC_RELEASE, "agent");
            asm volatile("s_waitcnt vmcnt(0)" ::: "memory");
            const unsigned og = xb_add(&bar[XB_TOP], 1u);
            const unsigned tg = og / nx;
            if (og + 1u == (tg + 1u) * nx) xb_add(&bar[XB_TOPGEN], 1u);
            else XB_SPIN(xb_ld(&bar[XB_TOPGEN]) == tg, bar);
            __builtin_amdgcn_fence(__ATOMIC_ACQUIRE, "agent");
            xb_add(&bar[XB_XGEN(b.x)], 1u);
            asm volatile("s_waitcnt vmcnt(0)" ::: "memory");
        } else {
            XB_SPIN(xb_ld(&bar[XB_XGEN(b.x)]) == gen, bar);
            __builtin_amdgcn_fence(__ATOMIC_ACQUIRE, "agent");
            asm volatile("s_waitcnt vmcnt(0)" ::: "memory");
        }
    }
    __syncthreads();
}

struct Args { const float* in[15]; float* out; unsigned char* ws; int lo, hi; };
__global__ void __launch_bounds__(512, 2) mk_fwd(Args a) {
    extern __shared__ __attribute__((aligned(16))) unsigned char lds_raw[];
    LAS unsigned char* lds = (LAS unsigned char*)lds_raw;
    cg::grid_group grid = cg::this_grid();
    const int tid = threadIdx.x, lane = tid & 63, wave = __builtin_amdgcn_readfirstlane(tid >> 6);
    const int G_ = gridDim.x, c_ = blockIdx.x;
    const float* x = a.in[0]; const float* ln_in_g = a.in[1]; const float* ln_in_b = a.in[2]; const float* w_in = a.in[3]; const float* hgrn_lb = a.in[4]; const float* hgrn_ng = a.in[5];
    const float* w_att = a.in[6]; const float* w_hg = a.in[7]; const float* w_o = a.in[8]; const float* ln1_g = a.in[9]; const float* ln1_b = a.in[10];
    const float* w_f1 = a.in[11]; const float* w_f2 = a.in[12]; const float* ln2_g = a.in[13]; const float* ln2_b = a.in[14];
    unsigned char* ws = a.ws;
    f32x2* STATS = (f32x2*)(ws + WS_STATS); float* LSE = (float*)(ws + WS_LSE);
    bf16_t* WT_in = (bf16_t*)(ws + WS_WTIN); bf16_t* WT_a = (bf16_t*)(ws + WS_WTA); bf16_t* WT_r = (bf16_t*)(ws + WS_WTR); bf16_t* WT_o = (bf16_t*)(ws + WS_WTO);
    bf16_t* WT_f1 = (bf16_t*)(ws + WS_WTF1); bf16_t* WT_f2 = (bf16_t*)(ws + WS_WTF2);
    unsigned char* R = ws + WS_R; unsigned char* O = ws + WS_O;
    bf16_t* GH = (bf16_t*)R;
    bf16_t* Qb = (bf16_t*)R; bf16_t* Kb = (bf16_t*)(R + 48 * MiB); bf16_t* Vb = (bf16_t*)(R + 96 * MiB);
    bf16_t* ATT = (bf16_t*)(R + 48 * MiB); bf16_t* M1 = (bf16_t*)R; bf16_t* M2 = (bf16_t*)(R + 64 * MiB); bf16_t* ACT = (bf16_t*)R;
    bf16_t* OFB = (bf16_t*)O; bf16_t* REC = (bf16_t*)O; float* H1F = (float*)O;
    bf16_t* HB = (bf16_t*)a.out; bf16_t* SHG = (bf16_t*)((unsigned char*)a.out + 32 * MiB); bf16_t* H1B = (bf16_t*)a.out;
    const int lo = a.lo, hi = a.hi;
    volatile LAS unsigned* stw = (volatile LAS unsigned*)(lds + 131072);
    if (tid < 2) stw[tid] = 0u;
    __syncthreads();
    XcdBarrier bar; bar.bar = (unsigned*)(ws + WS_BAR); bar.x = 0; bar.st = stw;
    if (hi - lo > 1) bar = xcd_barrier_post((unsigned*)(ws + WS_BAR), stw);
#ifndef MK_REP
#define MK_REP 0
#endif
#define IN(k) (lo <= (k) && (k) < hi)
#define REPS(k) (((MK_REP >> (k)) & 1) ? 2 : 1)
#define SEAM(k) do { if (IN(k) && IN((k) + 1)) { if ((k) == 0) { asm volatile("s_waitcnt vmcnt(0) lgkmcnt(0)" ::: "memory"); grid.sync(); __builtin_amdgcn_fence(__ATOMIC_ACQUIRE, "agent"); asm volatile("s_waitcnt vmcnt(0)" ::: "memory"); __syncthreads(); } else xcd_barrier(bar); } } while (0)
    const int gw = c_ * 8 + wave, NGW = G_ * 8;

    if (IN(0)) for (int rep_ = 0; rep_ < REPS(0); ++rep_) {
        LAS float* scr = (LAS float*)(lds + wave * 16384);
        constexpr int I0 = 16 * 368, I1 = 8 * 32, I2 = 16 * 32, I3 = 16 * 32, I4 = 16 * 176, I5 = 44 * 32;
        for (int it = gw; it < I0 + I1 + I2 + I3 + I4 + I5; it += NGW) { int r = it;
            if (r < I0) { tr_item(w_in, 11776, (r / 368) * 64, (r % 368) * 32, WT_in, 1024, (r % 368) * 32, scr, lane); continue; } r -= I0;
            if (r < I1) { tr_item(w_att, 1024, (r / 32) * 64, (r % 32) * 32, WT_a, 512, (r % 32) * 32, scr, lane); continue; } r -= I1;
            if (r < I2) { tr_item(w_hg, 1024, (r / 32) * 64, (r % 32) * 32, WT_r, 1024, (r % 32) * 32, scr, lane); continue; } r -= I2;
            if (r < I3) { tr_item(w_o, 1024, (r / 32) * 64, (r % 32) * 32, WT_o, 1024, (r % 32) * 32, scr, lane); continue; } r -= I3;
            if (r < I4) { const int nb = r % 176, r0 = nb * 32; const int pn = r0 >> 8, bj = (r0 >> 7) & 1, j = r0 & 127;
                tr_item(w_f1, 2 * DFF, (r / 176) * 64, bj * DFF + pn * 128 + j, WT_f1, 1024, r0, scr, lane); continue; } r -= I4;
            tr_item(w_f2, 1024, (r / 32) * 64, (r % 32) * 32, WT_f2, DFF, (r % 32) * 32, scr, lane); }
        for (int m = gw; m < TOK; m += NGW) ln_row<false, true, true>(x + (size_t)m * 1024, ln_in_g, ln_in_b, nullptr, HB + (size_t)m * 1024, STATS + m, lane);
    }
    SEAM(0);
    if (IN(1)) for (int rep_ = 0; rep_ < REPS(1); ++rep_) {
        pg8::Gemm g{HB, WT_in + (size_t)4608 * 1024, TOK, 5120, 1024}; pg8::StaticOrder S; S.init(TOK, 5120, G_, c_);
        EpiHg E{GH, SHG}; pg8::gemm_phase<EpiHg, pg8::StaticOrder>(lds, g, S, E, nullptr);
    }
    SEAM(1);
    if (IN(2)) for (int rep_ = 0; rep_ < REPS(2); ++rep_) hgrn_phase(lds, GH, hgrn_lb, OFB, tid, lane, wave);
    SEAM(2);
    if (IN(3)) for (int rep_ = 0; rep_ < REPS(3); ++rep_) {
        pg8::Gemm g{HB, WT_in, TOK, 4608, 1024}; pg8::StaticOrder S; S.init(TOK, 4608, G_, c_);
        EpiQKV E{Qb}; pg8::gemm_phase<EpiQKV, pg8::StaticOrder>(lds, g, S, E, nullptr);
    }
    SEAM(3);
    if (IN(4)) for (int rep_ = 0; rep_ < REPS(4); ++rep_) attn_phase(lds, Qb, Kb, Vb, LSE, tid, lane, wave);
    SEAM(4);
    if (IN(5)) for (int rep_ = 0; rep_ < REPS(5); ++rep_) combine_phase(Qb, LSE, ATT, OFB, OFB + (size_t)TOK * 1024, SHG, hgrn_ng, tid);
    SEAM(5);
    if (IN(6)) for (int rep_ = 0; rep_ < REPS(6); ++rep_) {
        pg8::StaticOrder S; S.init(TOK, 1024, G_, c_);
        { pg8::Gemm g{HB, WT_in + (size_t)9728 * 1024, TOK, 1024, 1024}; EpiMix<0> E{M1, nullptr}; pg8::gemm_phase<EpiMix<0>, pg8::StaticOrder>(lds, g, S, E, nullptr); }
        { pg8::Gemm g{ATT, WT_a, TOK, 1024, 512}; EpiMix<1> E{M1, nullptr}; pg8::gemm_phase<EpiMix<1>, pg8::StaticOrder>(lds, g, S, E, nullptr); }
        { pg8::Gemm g{HB, WT_in + (size_t)10752 * 1024, TOK, 1024, 1024}; EpiMix<0> E{M2, nullptr}; pg8::gemm_phase<EpiMix<0>, pg8::StaticOrder>(lds, g, S, E, nullptr); }
        { pg8::Gemm g{REC, WT_r, TOK, 1024, 1024}; EpiMix<2> E{M1, M2}; pg8::gemm_phase<EpiMix<2>, pg8::StaticOrder>(lds, g, S, E, nullptr); }
    }
    SEAM(6);
    if (IN(7)) for (int rep_ = 0; rep_ < REPS(7); ++rep_) {
        pg8::Gemm g{M1, WT_o, TOK, 1024, 1024}; pg8::StaticOrder S; S.init(TOK, 1024, G_, c_);
        EpiWo E{x, STATS, ln_in_g, ln_in_b, H1F}; pg8::gemm_phase<EpiWo, pg8::StaticOrder>(lds, g, S, E, nullptr);
    }
    SEAM(7);
    if (IN(8)) for (int rep_ = 0; rep_ < REPS(8); ++rep_) for (int m = gw; m < TOK; m += NGW) ln_row<true, true, false>(H1F + (size_t)m * 1024, ln1_g, ln1_b, H1F + (size_t)m * 1024, H1B + (size_t)m * 1024, nullptr, lane);
    SEAM(8);
    if (IN(9)) for (int rep_ = 0; rep_ < REPS(9); ++rep_) {
        pg8::Gemm g{H1B, WT_f1, TOK, 2 * DFF, 1024}; pg8::StaticOrder S; S.init(TOK, 2 * DFF, G_, c_);
        EpiFfnIn E{ACT}; pg8::gemm_phase<EpiFfnIn, pg8::StaticOrder>(lds, g, S, E, nullptr);
    }
    SEAM(9);
    if (IN(10)) for (int rep_ = 0; rep_ < REPS(10); ++rep_) {
        pg8::Gemm g{ACT, WT_f2, TOK, 1024, DFF}; pg8::StaticOrder S; S.init(TOK, 1024, G_, c_);
        EpiFfnOut E{H1F, a.out}; pg8::gemm_phase<EpiFfnOut, pg8::StaticOrder>(lds, g, S, E, nullptr);
    }
    SEAM(10);
    if (IN(11)) for (int rep_ = 0; rep_ < REPS(11); ++rep_) for (int m = gw; m < TOK; m += NGW) ln_row<true, false, false>(a.out + (size_t)m * 1024, ln2_g, ln2_b, a.out + (size_t)m * 1024, nullptr, nullptr, lane);
#undef IN
#undef SEAM
}

#ifndef MK_MULTI
#define MK_MULTI 0
#endif
extern "C" void kernel_launch(void* const* d_in, const int* in_sizes, int n_in, void* d_out, int out_size, void* d_ws, size_t ws_size, hipStream_t stream) {
    static int grid = 0;
    if (grid == 0) {
        int dev = 0, cus = 0, per_cu = 0;
        (void)hipGetDevice(&dev); (void)hipDeviceGetAttribute(&cus, hipDeviceAttributeMultiprocessorCount, dev);
        (void)hipFuncSetAttribute((const void*)mk_fwd, hipFuncAttributeMaxDynamicSharedMemorySize, LDS_BYTES);
        (void)hipOccupancyMaxActiveBlocksPerMultiprocessor(&per_cu, (const void*)mk_fwd, 512, LDS_BYTES);
        if (per_cu < 1) { fprintf(stderr, "kernel_launch: occupancy query says %d blocks per CU\n", per_cu); per_cu = 1; }
        grid = cus * 1;
        if (ws_size < 256 * MiB) fprintf(stderr, "kernel_launch: workspace too small (%zu)\n", ws_size);
    }
    Args a{};
    for (int i = 0; i < 15; ++i) a.in[i] = (const float*)d_in[i];
    a.out = (float*)d_out; a.ws = (unsigned char*)d_ws;
#if MK_MULTI
    for (int p = 0; p < NPHASE; ++p) { a.lo = p; a.hi = p + 1; hipLaunchKernelGGL(mk_fwd, dim3(grid), dim3(512), LDS_BYTES, stream, a); }
#else
    a.lo = 0; a.hi = NPHASE;
    (void)hipMemsetAsync((unsigned char*)d_ws + WS_BAR, 0, 16384, stream);
    void* args[] = {&a};
    hipError_t e = hipLaunchCooperativeKernel((const void*)mk_fwd, dim3(grid), dim3(512), args, LDS_BYTES, stream);
    if (e != hipSuccess) fprintf(stderr, "cooperative launch failed: %s (grid %d)\n", hipGetErrorString(e), grid);
#endif
}
```

```cpp
#include <hip/hip_runtime.h>
#include <hip/hip_cooperative_groups.h>
#include <cstdio>
namespace cg = cooperative_groups;
namespace pg8 {
#define PG8_LAS __attribute__((address_space(3)))
typedef unsigned short bf16_t;
typedef short bf16x8 __attribute__((ext_vector_type(8)));
typedef float f32x4 __attribute__((ext_vector_type(4)));
typedef unsigned u32x4 __attribute__((ext_vector_type(4)));
constexpr int BM = 256, BK = 64, HALF = 128, HTB = HALF * BK * 2  , STAGE_BYTES = 8 * HTB, NXCD = 8, WGM = 8;

__host__ __device__ __forceinline__ int lds_byte(int r, int c) { const int st = (r >> 4) * 2 + (c >> 5), rr = r & 15, cc = c & 31, ob = rr * 64 + cc * 2; return st * 1024 + (ob ^ (((ob >> 9) & 1) << 5)); }
__host__ __device__ __forceinline__ void stage_rc(int b, int& R, int& C) { const int st = b / 1024, sb = b % 1024, swz = sb ^ (((sb >> 9) & 1) << 5); R = (st >> 1) * 16 + swz / 64; C = (st & 1) * 32 + (swz % 64) / 2; }
__host__ __device__ __forceinline__ int perm32(int rho) { const int n = rho >> 4, i = rho & 15; return 8 * (i >> 2) + 4 * n + (i & 3); }

struct Unit { int pm, pn; };
struct Gemm { const bf16_t* A; const bf16_t* Bt; int M, N, K; };

struct StaticOrder {
    int nM, nN, nwg, G, c;
    __host__ __device__ void init(int M, int N, int G_, int c_) { nM = M / BM; nN = N / BM; nwg = nM * nN; G = G_; c = c_; }
    __host__ __device__ bool next(int i, Unit& u) const {
        const long L = (long)i * G + c; if (L >= nwg) return false;
        int wgid = (int)L; { const int q = nwg / NXCD, r = nwg % NXCD, xcd = wgid % NXCD, off = wgid / NXCD; wgid = (xcd < r ? xcd * (q + 1) : r * (q + 1) + (xcd - r) * q) + off; }
        const int nig = WGM * nN, gid = wgid / nig, fm = gid * WGM, gsz = (nM - fm) < WGM ? (nM - fm) : WGM;
        u.pm = fm + ((wgid % nig) % gsz); u.pn = (wgid % nig) / gsz; return true;
    }
    __device__ __forceinline__ void a_ready(const Unit&) const {}
    __device__ __forceinline__ void done(const Unit&) const {}
};
__device__ __forceinline__ unsigned cvt_pk_bf16(float lo, float hi) { unsigned r; asm volatile("v_cvt_pk_bf16_f32 %0, %1, %2" : "=v"(r) : "v"(lo), "v"(hi)); return r; }
typedef float f32x2 __attribute__((ext_vector_type(2)));
template <class Epi, class Sched, bool STAMP = false>
__device__ __forceinline__ void gemm_phase(PG8_LAS unsigned char* lds, const Gemm g, const Sched& S, const Epi& E, unsigned long long* stamps) {
    const int tid = threadIdx.x, wid = __builtin_amdgcn_readfirstlane(tid >> 6), lane = tid & 63, wr = wid >> 2, wc = wid & 3, fr = lane & 15, fq = lane >> 4;
    const int K = g.K, nt = K / BK;
    int ts_lo = 0, ts_hi = 0, nts = 0; const unsigned long long rt_entry = STAMP ? (unsigned long long)wall_clock64() : 0ull;
#define PG8_STAMP() do { if (STAMP && wid == 0 && nts < 64) { const unsigned long long _c = (unsigned long long)clock64(); \
        ts_lo = (lane == nts) ? (int)(unsigned)_c : ts_lo; ts_hi = (lane == nts) ? (int)(unsigned)(_c >> 32) : ts_hi; ++nts; } } while (0)
    PG8_STAMP();
    unsigned voffA[2], voffB[2];
#pragma unroll
    for (int i = 0; i < 2; ++i) { int R, C; stage_rc(tid * 16 + i * 8192, R, C); const int Rb = Epi::PERM ? ((R & ~31) + perm32(R & 31)) : R;
        voffA[i] = (unsigned)(R * K + C) * 2u; voffB[i] = (unsigned)(Rb * K + C) * 2u; }
    const size_t kstep = (size_t)(BK * 2);
    const size_t hstep = (size_t)HALF * K * 2;
    const size_t tstep = 2 * hstep;
    const unsigned ldsw = (unsigned)wid * 1024u;
    const int aoff = lds_byte(wr * 64 + fr, fq * 8), boff = lds_byte(wc * 32 + fr, fq * 8);
#define PG8_SA(b, h) (((b) * 2 + (h)) * HTB)
#define PG8_SB(b, h) ((4 + (b) * 2 + (h)) * HTB)
#define PG8_STAGE(bufoff, gbase, voff) do { _Pragma("unroll") for (int _i = 0; _i < 2; ++_i) \
        __builtin_amdgcn_global_load_lds((const unsigned*)((const char*)(gbase) + (voff)[_i]), (PG8_LAS unsigned*)(lds + (bufoff) + ldsw + _i * 8192), 16, 0, 0); } while (0)
#define PG8_LDA(dst, b, h) do { _Pragma("unroll") for (int m = 0; m < 4; ++m) _Pragma("unroll") for (int k = 0; k < 2; ++k) dst[m][k] = *(const PG8_LAS bf16x8*)(lds + PG8_SA(b, h) + aoff + m * 2048 + k * 1024); } while (0)
#define PG8_LDB(dst, b, h) do { _Pragma("unroll") for (int n = 0; n < 2; ++n) _Pragma("unroll") for (int k = 0; k < 2; ++k) dst[n][k] = *(const PG8_LAS bf16x8*)(lds + PG8_SB(b, h) + boff + n * 2048 + k * 1024); } while (0)
#define PG8_MMA(ai, bj, At, Bt) do { __builtin_amdgcn_s_setprio(1); _Pragma("unroll") for (int m = 0; m < 4; ++m) _Pragma("unroll") for (int n = 0; n < 2; ++n) _Pragma("unroll") for (int k = 0; k < 2; ++k) \
        acc[ai][bj][m][n] = __builtin_amdgcn_mfma_f32_16x16x32_bf16(Bt[n][k], At[m][k], acc[ai][bj][m][n], 0, 0, 0); __builtin_amdgcn_s_setprio(0); } while (0)
#define PG8_WAIT_V(n) asm volatile("s_waitcnt vmcnt(" #n ")" ::: "memory")
#define PG8_WAIT_L(n) asm volatile("s_waitcnt lgkmcnt(" #n ")" ::: "memory")
#define PG8_BAR __builtin_amdgcn_s_barrier()
#define PG8_SCHED __builtin_amdgcn_sched_barrier(0)
    Unit cur, nxt; int ui = 0;
    if (!S.next(0, cur)) return;
    f32x4 acc[2][2][4][2];
#pragma unroll
    for (int a = 0; a < 2; ++a)
#pragma unroll
        for (int b = 0; b < 2; ++b)
#pragma unroll
            for (int m = 0; m < 4; ++m)
#pragma unroll
                for (int n = 0; n < 2; ++n) acc[a][b][m][n] = (f32x4){0.f, 0.f, 0.f, 0.f};
    bf16x8 At[4][2], B0[2][2], B1[2][2];
    const char* cA = (const char*)g.A + (size_t)cur.pm * tstep; const char* cB = (const char*)g.Bt + (size_t)cur.pn * tstep;
    S.a_ready(cur);
    PG8_STAGE(PG8_SB(0, 0), cB, voffB); PG8_STAGE(PG8_SA(0, 0), cA, voffA); PG8_STAGE(PG8_SB(0, 1), cB + hstep, voffB); PG8_STAGE(PG8_SA(0, 1), cA + hstep, voffA);
    if (wr == 1) PG8_BAR;
    PG8_WAIT_V(4); PG8_BAR;
    PG8_STAGE(PG8_SB(1, 0), cB + kstep, voffB); PG8_STAGE(PG8_SA(1, 0), cA + kstep, voffA); PG8_STAGE(PG8_SB(1, 1), cB + hstep + kstep, voffB);
    PG8_WAIT_V(6); PG8_BAR;
    PG8_STAMP();
    for (;;) {
        const bool has_next = S.next(ui + 1, nxt);
        const char* nA = has_next ? (const char*)g.A + (size_t)nxt.pm * tstep : cA; const char* nB = has_next ? (const char*)g.Bt + (size_t)nxt.pn * tstep : cB;
        for (int t = 0; t < nt; t += 2) {
            const bool last = (t == nt - 2);
            const char* a1 = cA + (size_t)(t + 1) * kstep;
            const char* a2 = last ? nA : cA + (size_t)(t + 2) * kstep; const char* b2 = last ? nB : cB + (size_t)(t + 2) * kstep;
            const char* a3 = a2 + kstep; const char* b3 = b2 + kstep;
            if (last && has_next) S.a_ready(nxt);
            PG8_LDB(B0, 0, 0); PG8_SCHED; PG8_LDA(At, 0, 0); PG8_STAGE(PG8_SA(1, 1), a1 + hstep, voffA);
            PG8_WAIT_L(8); PG8_BAR; PG8_WAIT_L(0); PG8_MMA(0, 0, At, B0); PG8_BAR; PG8_SCHED;
            PG8_LDB(B1, 0, 1); PG8_STAGE(PG8_SB(0, 0), b2, voffB);
            PG8_BAR; PG8_WAIT_L(0); PG8_MMA(0, 1, At, B1); PG8_BAR;
            PG8_LDA(At, 0, 1); PG8_STAGE(PG8_SA(0, 0), a2, voffA);
            PG8_BAR; PG8_WAIT_L(0); PG8_MMA(1, 0, At, B0); PG8_BAR; PG8_SCHED;
            PG8_STAGE(PG8_SB(0, 1), b2 + hstep, voffB);
            PG8_WAIT_V(6); PG8_BAR; PG8_MMA(1, 1, At, B1); PG8_BAR;
            PG8_LDB(B0, 1, 0); PG8_SCHED; PG8_LDA(At, 1, 0); PG8_STAGE(PG8_SA(0, 1), a2 + hstep, voffA);
            PG8_WAIT_L(8); PG8_BAR; PG8_WAIT_L(0); PG8_MMA(0, 0, At, B0); PG8_BAR; PG8_SCHED;
            PG8_LDB(B1, 1, 1); PG8_STAGE(PG8_SB(1, 0), b3, voffB);
            PG8_BAR; PG8_WAIT_L(0); PG8_MMA(0, 1, At, B1); PG8_BAR;
            PG8_LDA(At, 1, 1); PG8_STAGE(PG8_SA(1, 0), a3, voffA);
            PG8_BAR; PG8_WAIT_L(0); PG8_MMA(1, 0, At, B0); PG8_BAR; PG8_SCHED;
            PG8_STAGE(PG8_SB(1, 1), b3 + hstep, voffB);
            PG8_WAIT_V(6); PG8_BAR; PG8_MMA(1, 1, At, B1); PG8_BAR;
        }
        PG8_STAMP();
        if constexpr (!Epi::AFTER_DRAIN) { E(acc, cur, wr, wc, fr, fq); S.done(cur); }
        PG8_STAMP();
        if (!has_next) break;
#pragma unroll
        for (int a = 0; a < 2; ++a)
#pragma unroll
            for (int b = 0; b < 2; ++b)
#pragma unroll
                for (int m = 0; m < 4; ++m)
#pragma unroll
                    for (int n = 0; n < 2; ++n) acc[a][b][m][n] = (f32x4){0.f, 0.f, 0.f, 0.f};
        cur = nxt; cA = nA; cB = nB; ++ui;
    }
    PG8_WAIT_V(0);
    if (wr == 0) PG8_BAR;
    PG8_BAR;
    if constexpr (Epi::AFTER_DRAIN) { E.fused(acc, cur, wr, wc, fr, fq, lds, wid, lane); S.done(cur); }
    PG8_STAMP();
    if (STAMP && wid == 0) { stamps[lane] = lane < nts ? (((unsigned long long)(unsigned)ts_hi << 32) | (unsigned)ts_lo) : 0ull;
        if (lane == 62) stamps[62] = rt_entry; if (lane == 63) stamps[63] = (unsigned long long)wall_clock64(); }
#undef PG8_STAMP
#undef PG8_SA
#undef PG8_SB
#undef PG8_STAGE
#undef PG8_LDA
#undef PG8_LDB
#undef PG8_MMA
#undef PG8_WAIT_V
#undef PG8_WAIT_L
#undef PG8_BAR
#undef PG8_SCHED
}
}
using pg8::bf16_t; using pg8::bf16x8; using pg8::f32x4; using pg8::u32x4; using pg8::Unit;
#define LAS __attribute__((address_space(3)))
typedef float f32x2 __attribute__((ext_vector_type(2)));
typedef unsigned u32x2 __attribute__((ext_vector_type(2)));

constexpr int TOK = 16384, DM = 1024, SEQ = 4096, DFF = 2816;
constexpr float ALPHA = 1.189207115002721f;
constexpr float LN_EPS = 1e-5f, RMS_EPS = 1e-6f;
constexpr size_t MiB = (size_t)1 << 20;
constexpr size_t WS_STATS = 0, WS_LSE = 1 * MiB, WS_WTIN = 3 * MiB, WS_WTA = 26 * MiB, WS_WTR = 27 * MiB, WS_WTO = 29 * MiB,
                 WS_WTF1 = 31 * MiB, WS_WTF2 = 42 * MiB, WS_R = 48 * MiB, WS_O = 192 * MiB;
constexpr int LDS_BYTES = 147456;
constexpr size_t WS_BAR = 2 * MiB + 512 * 1024;
constexpr int NPHASE = 13;

typedef float f32x2_t __attribute__((ext_vector_type(2)));
typedef __bf16 bf16v2_t __attribute__((ext_vector_type(2)));
__device__ __forceinline__ unsigned pk2(float lo, float hi) { f32x2_t v = {lo, hi}; bf16v2_t b = __builtin_convertvector(v, bf16v2_t); return __builtin_bit_cast(unsigned, b); }
__device__ __forceinline__ unsigned short f2bf(float f) { return (unsigned short)(pk2(f, 0.f) & 0xffffu); }
__device__ __forceinline__ float bf2f(unsigned short b) { return __uint_as_float(((unsigned)b) << 16); }
__device__ __forceinline__ float bflo(unsigned w) { return __uint_as_float(w << 16); }
__device__ __forceinline__ float bfhi(unsigned w) { return __uint_as_float(w & 0xffff0000u); }
__device__ __forceinline__ float fexp(float x) { return __builtin_amdgcn_exp2f(x * 1.4426950408889634f); }
__device__ __forceinline__ float flog(float x) { return __builtin_amdgcn_logf(x) * 0.6931471805599453f; }
__device__ __forceinline__ float frcp(float x) { return __builtin_amdgcn_rcpf(x); }
__device__ __forceinline__ float sigmoidf_(float x) { return frcp(1.0f + fexp(-x)); }
__device__ __forceinline__ float siluf_(float x) { return x * frcp(1.0f + fexp(-x)); }
__device__ __forceinline__ float wave_sum(float v) {
#pragma unroll
    for (int o = 1; o < 64; o <<= 1) v += __shfl_xor(v, o);
    return v;
}
#define LDS_WAIT() asm volatile("s_waitcnt lgkmcnt(0)" ::: "memory")

__device__ __forceinline__ u32x4 pack8(const f32x4& a, const f32x4& b) { u32x4 w; w.x = pk2(a[0], a[1]); w.y = pk2(a[2], a[3]); w.z = pk2(b[0], b[1]); w.w = pk2(b[2], b[3]); return w; }
__device__ __forceinline__ void unpack8(const u32x4& w, f32x4& a, f32x4& b) { a[0] = bflo(w.x); a[1] = bfhi(w.x); a[2] = bflo(w.y); a[3] = bfhi(w.y); b[0] = bflo(w.z); b[1] = bfhi(w.z); b[2] = bflo(w.w); b[3] = bfhi(w.w); }

struct EpiHg {
    static constexpr bool PERM = true, AFTER_DRAIN = false;
    bf16_t* G; bf16_t* SHG;
    __device__ __forceinline__ void operator()(const f32x4 (&acc)[2][2][4][2], const Unit& u, int wr, int wc, int fr, int fq) const {
        const int sec = u.pn >> 2;
        bf16_t* base = sec < 4 ? G : SHG; const int ld = sec < 4 ? 4096 : 1024; const int colt = sec < 4 ? u.pn * 256 : (u.pn - 16) * 256;
        const int row0 = u.pm * 256 + wr * 64 + fr, col0 = colt + wc * 32 + 8 * fq;
#pragma unroll
        for (int ai = 0; ai < 2; ++ai)
#pragma unroll
            for (int m = 0; m < 4; ++m) { bf16_t* rowp = base + (size_t)(row0 + ai * 128 + m * 16) * ld + col0;
#pragma unroll
                for (int bj = 0; bj < 2; ++bj) { f32x4 v0 = acc[ai][bj][m][0], v1 = acc[ai][bj][m][1];
                    if (sec == 0) {
#pragma unroll
                        for (int j = 0; j < 4; ++j) { v0[j] = siluf_(v0[j]) * 0.08838834764831845f; v1[j] = siluf_(v1[j]) * 0.08838834764831845f; } }
                    else if (sec == 4) {
#pragma unroll
                        for (int j = 0; j < 4; ++j) { v0[j] = siluf_(v0[j]); v1[j] = siluf_(v1[j]); } }
                    *(u32x4*)(rowp + bj * 128) = pack8(v0, v1); } }
    }
};
struct EpiQKV {
    static constexpr bool PERM = true, AFTER_DRAIN = false;
    bf16_t* QKV;
    __device__ __forceinline__ void operator()(const f32x4 (&acc)[2][2][4][2], const Unit& u, int wr, int wc, int fr, int fq) const {
        const int t = u.pn / 6; const int colt = (u.pn - 6 * t) * 256; const float sc = t == 0 ? 0.125f : 1.0f;
        bf16_t* base = QKV + (size_t)t * TOK * 1536;
        const int row0 = u.pm * 256 + wr * 64 + fr, col0 = colt + wc * 32 + 8 * fq;
#pragma unroll
        for (int ai = 0; ai < 2; ++ai)
#pragma unroll
            for (int m = 0; m < 4; ++m) { bf16_t* rowp = base + (size_t)(row0 + ai * 128 + m * 16) * 1536 + col0;
#pragma unroll
                for (int bj = 0; bj < 2; ++bj) *(u32x4*)(rowp + bj * 128) = pack8(acc[ai][bj][m][0] * sc, acc[ai][bj][m][1] * sc); }
    }
};
template <int MODE> struct EpiMix {
    static constexpr bool PERM = true, AFTER_DRAIN = false;
    bf16_t* O; const bf16_t* G2;
    __device__ __forceinline__ void operator()(const f32x4 (&acc)[2][2][4][2], const Unit& u, int wr, int wc, int fr, int fq) const {
        const int row0 = u.pm * 256 + wr * 64 + fr, col0 = u.pn * 256 + wc * 32 + 8 * fq;
#pragma unroll
        for (int ai = 0; ai < 2; ++ai)
#pragma unroll
            for (int m = 0; m < 4; ++m) { const size_t off = (size_t)(row0 + ai * 128 + m * 16) * 1024 + col0;
#pragma unroll
                for (int bj = 0; bj < 2; ++bj) { f32x4 v0 = acc[ai][bj][m][0], v1 = acc[ai][bj][m][1];
                    if (MODE == 0) {
#pragma unroll
                        for (int j = 0; j < 4; ++j) { v0[j] = sigmoidf_(v0[j]); v1[j] = sigmoidf_(v1[j]); } }
                    if (MODE == 1) { f32x4 p0, p1; unpack8(*(const u32x4*)(O + off + bj * 128), p0, p1); v0 = p0 * v0; v1 = p1 * v1; }
                    if (MODE == 2) { f32x4 p0, p1, g0, g1; unpack8(*(const u32x4*)(O + off + bj * 128), p0, p1); unpack8(*(const u32x4*)(G2 + off + bj * 128), g0, g1); v0 = p0 + g0 * v0; v1 = p1 + g1 * v1; }
                    *(u32x4*)(O + off + bj * 128) = pack8(v0, v1); } }
    }
};
struct EpiWo {
    static constexpr bool PERM = false, AFTER_DRAIN = false;
    const float* x; const f32x2* stats; const float* g; const float* b; float* Y;
    __device__ __forceinline__ void operator()(const f32x4 (&acc)[2][2][4][2], const Unit& u, int wr, int wc, int fr, int fq) const {
        const int row0 = u.pm * 256 + wr * 64 + fr, col0 = u.pn * 256 + wc * 32 + 4 * fq;
        f32x4 gv[2][2], bv[2][2];
#pragma unroll
        for (int bj = 0; bj < 2; ++bj)
#pragma unroll
            for (int n = 0; n < 2; ++n) { gv[bj][n] = *(const f32x4*)(g + col0 + bj * 128 + n * 16) * ALPHA; bv[bj][n] = *(const f32x4*)(b + col0 + bj * 128 + n * 16) * ALPHA; }
#pragma unroll
        for (int ai = 0; ai < 2; ++ai)
#pragma unroll
            for (int m = 0; m < 4; ++m) { const int row = row0 + ai * 128 + m * 16; const f32x2 st = stats[row]; const size_t off = (size_t)row * 1024 + col0;
#pragma unroll
                for (int bj = 0; bj < 2; ++bj)
#pragma unroll
                    for (int n = 0; n < 2; ++n) { const f32x4 xv = *(const f32x4*)(x + off + bj * 128 + n * 16);
                        *(f32x4*)(Y + off + bj * 128 + n * 16) = (xv - st.x) * st.y * gv[bj][n] + bv[bj][n] + acc[ai][bj][m][n]; }
                asm volatile("" ::: "memory"); }
    }
};
struct EpiFfnIn {
    static constexpr bool PERM = true, AFTER_DRAIN = false;
    bf16_t* ACT;
    __device__ __forceinline__ void operator()(const f32x4 (&acc)[2][2][4][2], const Unit& u, int wr, int wc, int fr, int fq) const {
        const int row0 = u.pm * 256 + wr * 64 + fr, col0 = u.pn * 128 + wc * 32 + 8 * fq;
#pragma unroll
        for (int ai = 0; ai < 2; ++ai)
#pragma unroll
            for (int m = 0; m < 4; ++m) { f32x4 v0, v1;
#pragma unroll
                for (int j = 0; j < 4; ++j) { v0[j] = siluf_(acc[ai][0][m][0][j]) * acc[ai][1][m][0][j]; v1[j] = siluf_(acc[ai][0][m][1][j]) * acc[ai][1][m][1][j]; }
                *(u32x4*)(ACT + (size_t)(row0 + ai * 128 + m * 16) * DFF + col0) = pack8(v0, v1); }
    }
};
struct EpiFfnOut {
    static constexpr bool PERM = false, AFTER_DRAIN = false;
    const float* H1; float* Y;
    __device__ __forceinline__ void operator()(const f32x4 (&acc)[2][2][4][2], const Unit& u, int wr, int wc, int fr, int fq) const {
        const int row0 = u.pm * 256 + wr * 64 + fr, col0 = u.pn * 256 + wc * 32 + 4 * fq;
#pragma unroll
        for (int ai = 0; ai < 2; ++ai)
#pragma unroll
            for (int m = 0; m < 4; ++m) { const size_t off = (size_t)(row0 + ai * 128 + m * 16) * 1024 + col0;
#pragma unroll
                for (int bj = 0; bj < 2; ++bj)
#pragma unroll
                    for (int n = 0; n < 2; ++n) { const f32x4 hv = *(const f32x4*)(H1 + off + bj * 128 + n * 16);
                        *(f32x4*)(Y + off + bj * 128 + n * 16) = hv * ALPHA + acc[ai][bj][m][n]; }
                asm volatile("" ::: "memory"); }
    }
};

__device__ __forceinline__ void tr_item(const float* __restrict__ W, int ldw, int k0, int c0, bf16_t* WT, int K, int r0, LAS float* scr, int lane) {
#pragma unroll 8
    for (int i = 0; i < 32; ++i) { const int kk = 2 * i + (lane >> 5); scr[kk * 33 + (lane & 31)] = W[(size_t)(k0 + kk) * ldw + c0 + (lane & 31)]; }
    LDS_WAIT();
    const int c = lane & 7;
#pragma unroll
    for (int j = 0; j < 4; ++j) { const int n = (lane >> 3) + 8 * j; const LAS float* s = scr + (8 * c) * 33 + n;
        u32x4 o; o.x = pk2(s[0 * 33], s[1 * 33]); o.y = pk2(s[2 * 33], s[3 * 33]); o.z = pk2(s[4 * 33], s[5 * 33]); o.w = pk2(s[6 * 33], s[7 * 33]);
        *(u32x4*)(WT + (size_t)(r0 + n) * K + k0 + 8 * c) = o; }
    LDS_WAIT();
}
template <bool WF32, bool WBF16, bool WSTATS>
__device__ __forceinline__ void ln_row(const float* in, const float* g, const float* b, float* outf, bf16_t* outb, f32x2* stat, int lane) {
    const f32x4* xr = (const f32x4*)in + lane;
    f32x4 v[4]; float s = 0.f;
#pragma unroll
    for (int j = 0; j < 4; ++j) { v[j] = xr[64 * j]; s += (v[j][0] + v[j][1]) + (v[j][2] + v[j][3]); }
    const float mean = wave_sum(s) * (1.f / 1024.f); float s2 = 0.f;
#pragma unroll
    for (int j = 0; j < 4; ++j) { v[j] = v[j] - mean; s2 += (v[j][0] * v[j][0] + v[j][1] * v[j][1]) + (v[j][2] * v[j][2] + v[j][3] * v[j][3]); }
    const float rstd = __builtin_amdgcn_rsqf(wave_sum(s2) * (1.f / 1024.f) + LN_EPS);
    if (WSTATS && lane == 0) *stat = (f32x2){mean, rstd};
#pragma unroll
    for (int j = 0; j < 4; ++j) { const f32x4 gv = ((const f32x4*)g)[lane + 64 * j], bv = ((const f32x4*)b)[lane + 64 * j];
        const f32x4 y = v[j] * rstd * gv + bv;
        if (WF32) ((f32x4*)outf)[lane + 64 * j] = y;
        if (WBF16) { u32x2 w; w.x = pk2(y[0], y[1]); w.y = pk2(y[2], y[3]); ((u32x2*)outb)[lane + 64 * j] = w; } }
}
#define MFMA16(a, b, c) __builtin_amdgcn_mfma_f32_16x16x32_bf16((a), (b), (c), 0, 0, 0)

__device__ __forceinline__ float bfsel(const u32x4& w, int c) { const unsigned x = w[c >> 1]; return (c & 1) ? bfhi(x) : bflo(x); }
template <bool FULL>
__device__ __forceinline__ void hgrn_pass(LAS unsigned char* lds, const bf16_t* __restrict__ G, const float* __restrict__ lbraw, bf16_t* __restrict__ OFB,
                                          float* ES, float* LS, int tid, int lane, int wave) {
    LAS unsigned char* sQ = lds;
    LAS unsigned char* sKi = lds + 17408;
    LAS unsigned char* sKdT = lds + 34816;
    LAS unsigned char* sVT = lds + 53248;
    LAS unsigned char* sA = lds + 71680;
    LAS unsigned char* sST = lds + 80896;
    LAS float* sDec = (LAS float*)(lds + 115712);
    const int fr = lane & 15, fq = lane >> 4;
    const int k0 = (2 * wave + (lane >> 5)) * 8, rgp = lane & 31, i0 = 2 * rgp;
    const int vrp = tid >> 4, vc = tid & 15;
    for (int it = blockIdx.x; it < 256; it += gridDim.x) {
        const int seg = it & 3, dir = (it >> 2) & 1, h = (it >> 3) & 7, b = it >> 6;
        if (!FULL && seg == 3) continue;
        float lb[8], oml[8];
#pragma unroll
        for (int c = 0; c < 8; ++c) { const float a0 = lbraw[dir * 2048 + h * 128 + k0 + c], a1 = lbraw[dir * 2048 + 1024 + h * 128 + k0 + c]; lb[c] = frcp(1.0f + fexp(a1 - a0)); oml[c] = 1.0f - lb[c]; }
        const bf16_t* Gb = G + (size_t)b * SEQ * 4096;
        bf16_t* Ob = OFB + (size_t)dir * TOK * 1024 + (size_t)b * SEQ * 1024 + h * 128;
        const int qoff = h * 128 + k0, foff = 1024 + dir * 1024 + h * 128 + k0, voff = 3072 + h * 128 + vc * 8;
        f32x4 Sacc[8];
#pragma unroll
        for (int vt = 0; vt < 8; ++vt) Sacc[vt] = (f32x4){0.f, 0.f, 0.f, 0.f};
        float Ltot[8];
#pragma unroll
        for (int c = 0; c < 8; ++c) Ltot[c] = 0.f;
        __syncthreads();
        if (FULL) {
            for (int s = 0; s < seg; ++s) { const int its = it - seg + s; float D[4];
#pragma unroll
                for (int jj = 0; jj < 4; ++jj) D[jj] = fexp(LS[its * 128 + 16 * wave + fq * 4 + jj]);
#pragma unroll
                for (int vt = 0; vt < 8; ++vt) { const f32x4 E = *(const f32x4*)(ES + ((size_t)(its * 8 + wave) * 8 + vt) * 256 + lane * 4);
#pragma unroll
                    for (int jj = 0; jj < 4; ++jj) Sacc[vt][jj] = D[jj] * Sacc[vt][jj] + E[jj]; } }
#pragma unroll
            for (int vt = 0; vt < 8; ++vt) { u32x2 w; w.x = pk2(Sacc[vt][0], Sacc[vt][1]); w.y = pk2(Sacc[vt][2], Sacc[vt][3]);
                *(LAS u32x2*)(sST + (vt * 16 + fr) * 272 + (16 * wave + fq * 4) * 2) = w; }
        }
        u32x4 qn[2], fn[2], vn[2];
#pragma unroll
        for (int r = 0; r < 2; ++r) { const int si = seg * 1024 + i0 + r; const int t = dir ? (SEQ - 1 - si) : si;
            if (FULL) qn[r] = *(const u32x4*)(Gb + (size_t)t * 4096 + qoff);
            fn[r] = *(const u32x4*)(Gb + (size_t)t * 4096 + foff);
            const int sv = seg * 1024 + 2 * vrp + r; const int tv = dir ? (SEQ - 1 - sv) : sv; vn[r] = *(const u32x4*)(Gb + (size_t)tv * 4096 + voff); }
        __syncthreads();
        for (int n = 0; n < 16; ++n) {
            float kk[2][8], cum[2][8], tot[8], qv[2][8];
#pragma unroll
            for (int c = 0; c < 8; ++c) { float lf[2];
#pragma unroll
                for (int r = 0; r < 2; ++r) { const float x = bfsel(fn[r], c); const float e = fexp(-fabsf(x)); const float sa = frcp(1.0f + e), sbm = e * sa;
                    const float sg = x >= 0.f ? sa : sbm, om = x >= 0.f ? sbm : sa; lf[r] = flog(lb[c] + oml[c] * sg); kk[r][c] = oml[c] * om; if (FULL) qv[r][c] = bfsel(qn[r], c); }
                const float c1 = lf[0] + lf[1]; float inc = c1;
#pragma unroll
                for (int d = 1; d < 32; d <<= 1) { const float t = __shfl_up(inc, d, 32); inc += (rgp >= d) ? t : 0.f; }
                cum[0][c] = (inc - c1) + lf[0]; cum[1][c] = inc; tot[c] = __shfl(inc, 31, 32); Ltot[c] += tot[c]; }
            const u32x4 v0 = vn[0], v1 = vn[1];
            if (n + 1 < 16) {
#pragma unroll
                for (int r = 0; r < 2; ++r) { const int si = seg * 1024 + (n + 1) * 64 + i0 + r; const int t = dir ? (SEQ - 1 - si) : si;
                    if (FULL) qn[r] = *(const u32x4*)(Gb + (size_t)t * 4096 + qoff);
                    fn[r] = *(const u32x4*)(Gb + (size_t)t * 4096 + foff);
                    const int sv = seg * 1024 + (n + 1) * 64 + 2 * vrp + r; const int tv = dir ? (SEQ - 1 - sv) : sv; vn[r] = *(const u32x4*)(Gb + (size_t)tv * 4096 + voff); }
            }
            {
                float kd[2][8];
#pragma unroll
                for (int r = 0; r < 2; ++r) { float qd[8], ki[8];
#pragma unroll
                    for (int c = 0; c < 8; ++c) { const float ec = fexp(cum[r][c]); kd[r][c] = kk[r][c] * fexp(tot[c] - cum[r][c]);
                        if (FULL) { qd[c] = qv[r][c] * ec; ki[c] = kk[r][c] * fexp(-cum[r][c]); } }
                    if (FULL) { u32x4 wq, wk; wq.x = pk2(qd[0], qd[1]); wq.y = pk2(qd[2], qd[3]); wq.z = pk2(qd[4], qd[5]); wq.w = pk2(qd[6], qd[7]);
                        wk.x = pk2(ki[0], ki[1]); wk.y = pk2(ki[2], ki[3]); wk.z = pk2(ki[4], ki[5]); wk.w = pk2(ki[6], ki[7]);
                        *(LAS u32x4*)(sQ + (i0 + r) * 272 + k0 * 2) = wq; *(LAS u32x4*)(sKi + (i0 + r) * 272 + k0 * 2) = wk; } }
#pragma unroll
                for (int c = 0; c < 8; ++c) *(LAS unsigned*)(sKdT + (k0 + c) * 144 + i0 * 2) = pk2(kd[0][c], kd[1][c]);
                if (rgp == 0) {
#pragma unroll
                    for (int c = 0; c < 8; ++c) sDec[k0 + c] = fexp(tot[c]); }
#pragma unroll
                for (int c = 0; c < 8; ++c) { const unsigned a = v0[c >> 1], bb = v1[c >> 1];
                    const unsigned w = (c & 1) ? ((a >> 16) | (bb & 0xffff0000u)) : ((a & 0xffffu) | (bb << 16));
                    *(LAS unsigned*)(sVT + (vc * 8 + c) * 144 + (2 * vrp) * 2) = w; }
            }
            __syncthreads();
            const int ti = wave >> 1, vh = wave & 1;
            f32x4 oT[4];
            if (FULL) {
#pragma unroll
                for (int t2 = 0; t2 < 2; ++t2) { const int tj = (wave & 1) * 2 + t2;
                    f32x4 a = (f32x4){0.f, 0.f, 0.f, 0.f};
                    if (tj <= ti) {
#pragma unroll
                        for (int ks = 0; ks < 4; ++ks) { const bf16x8 A = *(const LAS bf16x8*)(sQ + (ti * 16 + fr) * 272 + fq * 16 + ks * 64);
                            const bf16x8 B = *(const LAS bf16x8*)(sKi + (tj * 16 + fr) * 272 + fq * 16 + ks * 64); a = MFMA16(A, B, a); } }
#pragma unroll
                    for (int jj = 0; jj < 4; ++jj) { const int i = ti * 16 + fq * 4 + jj, j = tj * 16 + fr;
                        const float val = (j <= i) ? a[jj] : 0.f; *(LAS unsigned short*)(sA + i * 144 + j * 2) = f2bf(val); } }
#pragma unroll
                for (int vt = 0; vt < 4; ++vt) oT[vt] = (f32x4){0.f, 0.f, 0.f, 0.f};
#pragma unroll
                for (int ks = 0; ks < 4; ++ks) { const bf16x8 Bq = *(const LAS bf16x8*)(sQ + (ti * 16 + fr) * 272 + fq * 16 + ks * 64);
#pragma unroll
                    for (int vt = 0; vt < 4; ++vt) { const bf16x8 Av = *(const LAS bf16x8*)(sST + (vh * 64 + vt * 16 + fr) * 272 + fq * 16 + ks * 64); oT[vt] = MFMA16(Av, Bq, oT[vt]); } }
                __syncthreads();
#pragma unroll
                for (int ks = 0; ks < 2; ++ks) { const bf16x8 Ba = *(const LAS bf16x8*)(sA + (ti * 16 + fr) * 144 + fq * 16 + ks * 64);
#pragma unroll
                    for (int vt = 0; vt < 4; ++vt) { const bf16x8 Av = *(const LAS bf16x8*)(sVT + (vh * 64 + vt * 16 + fr) * 144 + fq * 16 + ks * 64); oT[vt] = MFMA16(Av, Ba, oT[vt]); } }
                { const int si = seg * 1024 + n * 64 + ti * 16 + fr; const int t = dir ? (SEQ - 1 - si) : si; bf16_t* op = Ob + (size_t)t * 1024 + vh * 64 + fq * 4;
#pragma unroll
                  for (int vt = 0; vt < 4; ++vt) { u32x2 w; w.x = pk2(oT[vt][0], oT[vt][1]); w.y = pk2(oT[vt][2], oT[vt][3]); *(u32x2*)(op + vt * 16) = w; } }
            }
            { float d[4];
#pragma unroll
              for (int jj = 0; jj < 4; ++jj) d[jj] = sDec[16 * wave + fq * 4 + jj];
#pragma unroll
              for (int vt = 0; vt < 8; ++vt)
#pragma unroll
                  for (int jj = 0; jj < 4; ++jj) Sacc[vt][jj] *= d[jj]; }
#pragma unroll
            for (int ks = 0; ks < 2; ++ks) { const bf16x8 A = *(const LAS bf16x8*)(sKdT + (16 * wave + fr) * 144 + fq * 16 + ks * 64);
#pragma unroll
                for (int vt = 0; vt < 8; ++vt) { const bf16x8 B = *(const LAS bf16x8*)(sVT + (vt * 16 + fr) * 144 + fq * 16 + ks * 64); Sacc[vt] = MFMA16(A, B, Sacc[vt]); } }
            if (FULL) {
#pragma unroll
                for (int vt = 0; vt < 8; ++vt) { u32x2 w; w.x = pk2(Sacc[vt][0], Sacc[vt][1]); w.y = pk2(Sacc[vt][2], Sacc[vt][3]);
                    *(LAS u32x2*)(sST + (vt * 16 + fr) * 272 + (16 * wave + fq * 4) * 2) = w; } }
            __syncthreads();
        }
        if (!FULL) {
#pragma unroll
            for (int vt = 0; vt < 8; ++vt) *(f32x4*)(ES + ((size_t)(it * 8 + wave) * 8 + vt) * 256 + lane * 4) = Sacc[vt];
            if (rgp == 0) {
#pragma unroll
                for (int c = 0; c < 8; ++c) LS[it * 128 + k0 + c] = Ltot[c]; }
        }
    }
}

__device__ __forceinline__ void attn_phase(LAS unsigned char* lds, bf16_t* Q, const bf16_t* __restrict__ K, const bf16_t* __restrict__ V, float* __restrict__ LSE, int tid, int lane, int wave, bool dry = false) {
    LAS unsigned char* sK = lds;
    LAS unsigned char* sVT = lds + 39168;
    const int fr = lane & 15, fq = lane >> 4;
    for (int it = blockIdx.x; it < 3072; it += gridDim.x) {
        const int g = it >> 10, rem = it & 1023, b = rem >> 8, h = (rem >> 5) & 7, sb = rem & 31;
        const int dsh = 2 * g, dil = 1 << dsh, m = SEQ >> dsh, spb = 32 >> dsh;
        const int r = sb >> (5 - dsh), q0 = (sb & (spb - 1)) * 128;
        const int colbase = g * 512 + h * 64;
        __syncthreads();
        for (int e = tid; e < 2176; e += 512) { const int j = e >> 3, c = e & 7; const int kx = q0 - 64 + j; const bool valid = kx >= 0 && kx < m;
            const size_t off = (size_t)(b * SEQ + (valid ? kx : 0) * dil + r) * 1536 + colbase + c * 8;
            u32x4 kv = *(const u32x4*)(K + off), vv = *(const u32x4*)(V + off);
            if (!valid) { kv = (u32x4){0u, 0u, 0u, 0u}; vv = kv; }
            *(LAS u32x4*)(sK + j * 144 + c * 16) = kv;
            LAS unsigned char* p = sVT + (c * 8) * 552 + j * 2;
            *(LAS unsigned short*)(p + 0 * 552) = (unsigned short)(vv.x & 0xffffu); *(LAS unsigned short*)(p + 1 * 552) = (unsigned short)(vv.x >> 16);
            *(LAS unsigned short*)(p + 2 * 552) = (unsigned short)(vv.y & 0xffffu); *(LAS unsigned short*)(p + 3 * 552) = (unsigned short)(vv.y >> 16);
            *(LAS unsigned short*)(p + 4 * 552) = (unsigned short)(vv.z & 0xffffu); *(LAS unsigned short*)(p + 5 * 552) = (unsigned short)(vv.z >> 16);
            *(LAS unsigned short*)(p + 6 * 552) = (unsigned short)(vv.w & 0xffffu); *(LAS unsigned short*)(p + 7 * 552) = (unsigned short)(vv.w >> 16); }
        const int qtok = b * SEQ + (q0 + 16 * wave + fr) * dil + r;
        bf16_t* qrow = Q + (size_t)qtok * 1536 + colbase;
        bf16x8 qf[2]; qf[0] = *(const bf16x8*)(qrow + fq * 8); qf[1] = *(const bf16x8*)(qrow + fq * 8 + 32);
        __syncthreads();
        f32x4 s[10];
#pragma unroll
        for (int kt = 0; kt < 10; ++kt) { f32x4 a = (f32x4){0.f, 0.f, 0.f, 0.f};
#pragma unroll
            for (int ks = 0; ks < 2; ++ks) { const bf16x8 A = *(const LAS bf16x8*)(sK + (16 * (wave + kt) + fr) * 144 + fq * 16 + ks * 64); a = MFMA16(A, qf[ks], a); }
            s[kt] = a; }
        const float sd = exp2f(-(float)(g * 8 + h + 1) * (1.0f / 3.0f)) * (float)dil;
        float mx = -1e30f;
#pragma unroll
        for (int kt = 0; kt < 10; ++kt)
#pragma unroll
            for (int jj = 0; jj < 4; ++jj) { const int rel = -64 + 16 * kt + fq * 4 + jj - fr; const int kx = q0 - 64 + 16 * (wave + kt) + fq * 4 + jj;
                const int ar = rel < 0 ? -rel : rel; const bool valid = ar <= 64 && kx >= 0 && kx < m;
                const float v = valid ? s[kt][jj] - sd * (float)ar : -1e30f; s[kt][jj] = v; mx = fmaxf(mx, v); }
        mx = fmaxf(mx, __shfl_xor(mx, 16)); mx = fmaxf(mx, __shfl_xor(mx, 32));
        float lsum = 0.f;
#pragma unroll
        for (int kt = 0; kt < 10; ++kt)
#pragma unroll
            for (int jj = 0; jj < 4; ++jj) { const float p = fexp(s[kt][jj] - mx); s[kt][jj] = p; lsum += p; }
        lsum += __shfl_xor(lsum, 16); lsum += __shfl_xor(lsum, 32);
        f32x4 o[4];
#pragma unroll
        for (int dt = 0; dt < 4; ++dt) o[dt] = (f32x4){0.f, 0.f, 0.f, 0.f};
#pragma unroll
        for (int sp = 0; sp < 5; ++sp) {
            union { u32x4 u; bf16x8 v; } pb; pb.u.x = pk2(s[2 * sp][0], s[2 * sp][1]); pb.u.y = pk2(s[2 * sp][2], s[2 * sp][3]); pb.u.z = pk2(s[2 * sp + 1][0], s[2 * sp + 1][1]); pb.u.w = pk2(s[2 * sp + 1][2], s[2 * sp + 1][3]);
#pragma unroll
            for (int dt = 0; dt < 4; ++dt) { const LAS unsigned char* vp = sVT + (dt * 16 + fr) * 552 + (16 * (wave + 2 * sp) + fq * 4) * 2;
                const u32x2 lo = *(const LAS u32x2*)(vp), hi = *(const LAS u32x2*)(vp + 32);
                union { u32x4 u; bf16x8 v; } va; va.u.x = lo.x; va.u.y = lo.y; va.u.z = hi.x; va.u.w = hi.y;
                o[dt] = MFMA16(va.v, pb.v, o[dt]); } }
        const float inv = frcp(lsum);
#pragma unroll
        for (int dt = 0; dt < 4; ++dt) { u32x2 w; w.x = pk2(o[dt][0] * inv, o[dt][1] * inv); w.y = pk2(o[dt][2] * inv, o[dt][3] * inv);
            if (!dry || lsum < 0.f) *(u32x2*)(qrow + dt * 16 + fq * 4) = w; }
        if (fq == 0) LSE[((size_t)g * TOK + qtok) * 8 + h] = mx + flog(lsum);
    }
}

__device__ __forceinline__ void combine_phase(const bf16_t* __restrict__ Qo, const float* __restrict__ LSE, bf16_t* __restrict__ ATT,
                                              bf16_t* OF, const bf16_t* __restrict__ OB, const bf16_t* __restrict__ SHG, const float* __restrict__ ng, int tid) {
    const int gt = blockIdx.x * 512 + tid, gs = gridDim.x * 512;
    for (int idx = gt; idx < TOK * 64; idx += gs) { const int tok = idx >> 6, ch = idx & 63, h = ch >> 3;
        const float l0 = LSE[((size_t)0 * TOK + tok) * 8 + h], l1 = LSE[((size_t)1 * TOK + tok) * 8 + h], l2 = LSE[((size_t)2 * TOK + tok) * 8 + h];
        const float mx = fmaxf(l0, fmaxf(l1, l2)); float e0 = fexp(l0 - mx), e1 = fexp(l1 - mx), e2 = fexp(l2 - mx); const float inv = frcp(e0 + e1 + e2); e0 *= inv; e1 *= inv; e2 *= inv;
        const bf16_t* p = Qo + (size_t)tok * 1536 + ch * 8;
        f32x4 a0, a1, b0, b1, c0, c1; unpack8(*(const u32x4*)(p), a0, a1); unpack8(*(const u32x4*)(p + 512), b0, b1); unpack8(*(const u32x4*)(p + 1024), c0, c1);
        *(u32x4*)(ATT + (size_t)tok * 512 + ch * 8) = pack8(a0 * e0 + b0 * e1 + c0 * e2, a1 * e0 + b1 * e1 + c1 * e2); }
    for (int idx = gt; idx < TOK * 128; idx += gs) { const int tok = idx >> 7, col = (idx & 127) * 8; const size_t off = (size_t)tok * 1024 + col;
        f32x4 a0, a1, b0, b1, s0, s1; unpack8(*(const u32x4*)(OF + off), a0, a1); unpack8(*(const u32x4*)(OB + off), b0, b1); unpack8(*(const u32x4*)(SHG + off), s0, s1);
        a0 = a0 + b0; a1 = a1 + b1;
        float ss = (a0[0] * a0[0] + a0[1] * a0[1]) + (a0[2] * a0[2] + a0[3] * a0[3]) + (a1[0] * a1[0] + a1[1] * a1[1]) + (a1[2] * a1[2] + a1[3] * a1[3]);
        ss += __shfl_xor(ss, 1); ss += __shfl_xor(ss, 2); ss += __shfl_xor(ss, 4); ss += __shfl_xor(ss, 8);
        const float rs = __builtin_amdgcn_rsqf(ss * (1.0f / 128.0f) + RMS_EPS);
        const f32x4 g0 = *(const f32x4*)(ng + (col & 127)), g1 = *(const f32x4*)(ng + (col & 127) + 4);
        *(u32x4*)(OF + off) = pack8(a0 * rs * g0 * s0, a1 * rs * g1 * s1); }
}

#define XB_TMO      128
#define XB_XCNT(j)  (256  + 64 * (j))
#define XB_XSUB(j)  (1280 + 64 * (j))
#define XB_XGEN(j)  (2304 + 64 * (j))
#define XB_TOP      3328
#define XB_TOPGEN   3392
#define XCD_BAR_WORDS 3456
#define XB_SPIN_CAP (1u << 18)

__device__ __forceinline__ unsigned xb_ld(unsigned* p)              { return __hip_atomic_load(p, __ATOMIC_RELAXED, __HIP_MEMORY_SCOPE_AGENT); }
__device__ __forceinline__ unsigned xb_add(unsigned* p, unsigned v) { return __hip_atomic_fetch_add(p, v, __ATOMIC_RELAXED, __HIP_MEMORY_SCOPE_AGENT); }
__device__ __forceinline__ unsigned xb_xcc_id() { return (unsigned)__builtin_amdgcn_s_getreg((3 << 11) | 20) & 0xFu; }
#define XB_SPIN(cond, bar) do { unsigned _sp = 0; while (cond) { __builtin_amdgcn_s_sleep(1); \
    if ((++_sp & 255u) == 0u) { if (xb_ld(&(bar)[XB_TMO])) break; if (_sp > XB_SPIN_CAP) { atomicAdd(&(bar)[XB_TMO], 1u); break; } } } } while (0)

struct XcdBarrier {
    unsigned* bar; unsigned x;
    volatile LAS unsigned* st;
};

__device__ __forceinline__ XcdBarrier xcd_barrier_post(unsigned* bar, volatile LAS unsigned* st) {
    XcdBarrier b; b.bar = bar; b.x = xb_xcc_id(); b.st = st;
    if (threadIdx.x == 0) (void)xb_add(&bar[XB_XCNT(b.x)], 1u);
    return b;
}
__device__ __forceinline__ void xcd_barrier_complete(unsigned* bar, unsigned x, unsigned& nloc, unsigned& nx) {
    const unsigned G = gridDim.x * gridDim.y * gridDim.z;
    unsigned sum, cnt, mine, sp = 0u;
    for (;;) {
        sum = 0u; cnt = 0u; mine = 0u;
#pragma unroll
        for (unsigned j = 0; j < 16; ++j) { const unsigned c = xb_ld(&bar[XB_XCNT(j)]); sum += c; cnt += (c > 0u) ? 1u : 0u; mine = (j == x) ? c : mine; }
        if (sum == G) break;
        __builtin_amdgcn_s_sleep(1);
        if ((++sp & 255u) == 0u) { if (xb_ld(&bar[XB_TMO])) break; if (sp > XB_SPIN_CAP) { atomicAdd(&bar[XB_TMO], 1u); break; } }
    }
    nloc = mine > 0u ? mine : 1u; nx = cnt > 0u ? cnt : 1u;
}

__device__ __forceinline__ void xcd_barrier(const XcdBarrier& b) {
    asm volatile("s_waitcnt vmcnt(0)" ::: "memory");
    __syncthreads();
    if (threadIdx.x == 0) {
        unsigned* bar = b.bar;
        __builtin_amdgcn_s_waitcnt(0);
        unsigned nloc = b.st[0], nx = b.st[1];
        if (nloc == 0u) { xcd_barrier_complete(bar, b.x, nloc, nx); b.st[0] = nloc; b.st[1] = nx; }
        const unsigned old = xb_add(&bar[XB_XSUB(b.x)], 1u);
        const unsigned gen = old / nloc;
        if (old + 1u == (gen + 1u) * nloc) {
            __builtin_amdgcn_fence(__ATOMIC_RELEASE, "agent");
            asm volatile("s_waitcnt vmcnt(0)" ::: "memory");
            const unsigned og = xb_add(&bar[XB_TOP], 1u);
            const unsigned tg = og / nx;
            if (og + 1u == (tg + 1u) * nx) xb_add(&bar[XB_TOPGEN], 1u);
            else XB_SPIN(xb_ld(&bar[XB_TOPGEN]) == tg, bar);
            __builtin_amdgcn_fence(__ATOMIC_ACQUIRE, "agent");
            xb_add(&bar[XB_XGEN(b.x)], 1u);
            asm volatile("s_waitcnt vmcnt(0)" ::: "memory");
        } else {
            XB_SPIN(xb_ld(&bar[XB_XGEN(b.x)]) == gen, bar);
            __builtin_amdgcn_fence(__ATOMIC_ACQUIRE, "agent");
            asm volatile("s_waitcnt vmcnt(0)" ::: "memory");
        }
    }
    __syncthreads();
}

struct Args { const float* in[15]; float* out; unsigned char* ws; int lo, hi; };
__global__ void __launch_bounds__(512, 2) mk_fwd(Args a) {
    extern __shared__ __attribute__((aligned(16))) unsigned char lds_raw[];
    LAS unsigned char* lds = (LAS unsigned char*)lds_raw;
    cg::grid_group grid = cg::this_grid();
    const int tid = threadIdx.x, lane = tid & 63, wave = __builtin_amdgcn_readfirstlane(tid >> 6);
    const int G_ = gridDim.x, c_ = blockIdx.x;
    const float* x = a.in[0]; const float* ln_in_g = a.in[1]; const float* ln_in_b = a.in[2]; const float* w_in = a.in[3]; const float* hgrn_lb = a.in[4]; const float* hgrn_ng = a.in[5];
    const float* w_att = a.in[6]; const float* w_hg = a.in[7]; const float* w_o = a.in[8]; const float* ln1_g = a.in[9]; const float* ln1_b = a.in[10];
    const float* w_f1 = a.in[11]; const float* w_f2 = a.in[12]; const float* ln2_g = a.in[13]; const float* ln2_b = a.in[14];
    unsigned char* ws = a.ws;
    f32x2* STATS = (f32x2*)(ws + WS_STATS); float* LSE = (float*)(ws + WS_LSE);
    bf16_t* WT_in = (bf16_t*)(ws + WS_WTIN); bf16_t* WT_a = (bf16_t*)(ws + WS_WTA); bf16_t* WT_r = (bf16_t*)(ws + WS_WTR); bf16_t* WT_o = (bf16_t*)(ws + WS_WTO);
    bf16_t* WT_f1 = (bf16_t*)(ws + WS_WTF1); bf16_t* WT_f2 = (bf16_t*)(ws + WS_WTF2);
    unsigned char* R = ws + WS_R; unsigned char* O = ws + WS_O;
    bf16_t* GH = (bf16_t*)R;
    bf16_t* Qb = (bf16_t*)R; bf16_t* Kb = (bf16_t*)(R + 48 * MiB); bf16_t* Vb = (bf16_t*)(R + 96 * MiB);
    bf16_t* ATT = (bf16_t*)(R + 48 * MiB); bf16_t* M1 = (bf16_t*)R; bf16_t* M2 = (bf16_t*)(R + 64 * MiB); bf16_t* ACT = (bf16_t*)R;
    float* HES = (float*)(R + 128 * MiB); float* HLS = (float*)(ws + WS_BAR + 65536);
    bf16_t* OFB = (bf16_t*)O; bf16_t* REC = (bf16_t*)O; float* H1F = (float*)O;
    bf16_t* HB = (bf16_t*)a.out; bf16_t* SHG = (bf16_t*)((unsigned char*)a.out + 32 * MiB); bf16_t* H1B = (bf16_t*)a.out;
    const int lo = a.lo, hi = a.hi;
    volatile LAS unsigned* stw = (volatile LAS unsigned*)(lds + 131072);
    if (tid < 2) stw[tid] = 0u;
    __syncthreads();
    XcdBarrier bar; bar.bar = (unsigned*)(ws + WS_BAR); bar.x = 0; bar.st = stw;
    if (hi - lo > 1) bar = xcd_barrier_post((unsigned*)(ws + WS_BAR), stw);
#ifndef MK_REP
#define MK_REP 0
#endif
#define IN(k) (lo <= (k) && (k) < hi)
#define REPS(k) (((MK_REP >> (k)) & 1) ? 2 : 1)
#define SEAM(k) do { if (IN(k) && IN((k) + 1)) { if ((k) == 0) { asm volatile("s_waitcnt vmcnt(0) lgkmcnt(0)" ::: "memory"); grid.sync(); __builtin_amdgcn_fence(__ATOMIC_ACQUIRE, "agent"); asm volatile("s_waitcnt vmcnt(0)" ::: "memory"); __syncthreads(); } else xcd_barrier(bar); } } while (0)
    const int gw = c_ * 8 + wave, NGW = G_ * 8;

    if (IN(0)) for (int rep_ = 0; rep_ < REPS(0); ++rep_) {
        LAS float* scr = (LAS float*)(lds + wave * 16384);
        constexpr int I0 = 16 * 368, I1 = 8 * 32, I2 = 16 * 32, I3 = 16 * 32, I4 = 16 * 176, I5 = 44 * 32;
        for (int it = gw; it < I0 + I1 + I2 + I3 + I4 + I5; it += NGW) { int r = it;
            if (r < I0) { tr_item(w_in, 11776, (r / 368) * 64, (r % 368) * 32, WT_in, 1024, (r % 368) * 32, scr, lane); continue; } r -= I0;
            if (r < I1) { tr_item(w_att, 1024, (r / 32) * 64, (r % 32) * 32, WT_a, 512, (r % 32) * 32, scr, lane); continue; } r -= I1;
            if (r < I2) { tr_item(w_hg, 1024, (r / 32) * 64, (r % 32) * 32, WT_r, 1024, (r % 32) * 32, scr, lane); continue; } r -= I2;
            if (r < I3) { tr_item(w_o, 1024, (r / 32) * 64, (r % 32) * 32, WT_o, 1024, (r % 32) * 32, scr, lane); continue; } r -= I3;
            if (r < I4) { const int nb = r % 176, r0 = nb * 32; const int pn = r0 >> 8, bj = (r0 >> 7) & 1, j = r0 & 127;
                tr_item(w_f1, 2 * DFF, (r / 176) * 64, bj * DFF + pn * 128 + j, WT_f1, 1024, r0, scr, lane); continue; } r -= I4;
            tr_item(w_f2, 1024, (r / 32) * 64, (r % 32) * 32, WT_f2, DFF, (r % 32) * 32, scr, lane); }
        for (int m = gw; m < TOK; m += NGW) ln_row<false, true, true>(x + (size_t)m * 1024, ln_in_g, ln_in_b, nullptr, HB + (size_t)m * 1024, STATS + m, lane);
    }
    SEAM(0);
    if (IN(1)) for (int rep_ = 0; rep_ < REPS(1); ++rep_) {
        pg8::Gemm g{HB, WT_in + (size_t)4608 * 1024, TOK, 5120, 1024}; pg8::StaticOrder S; S.init(TOK, 5120, G_, c_);
        EpiHg E{GH, SHG}; pg8::gemm_phase<EpiHg, pg8::StaticOrder>(lds, g, S, E, nullptr);
    }
    SEAM(1);
    if (IN(2)) for (int rep_ = 0; rep_ < REPS(2); ++rep_) hgrn_pass<false>(lds, GH, hgrn_lb, OFB, HES, HLS, tid, lane, wave);
    SEAM(2);
    if (IN(3)) for (int rep_ = 0; rep_ < REPS(3); ++rep_) hgrn_pass<true>(lds, GH, hgrn_lb, OFB, HES, HLS, tid, lane, wave);
    SEAM(3);
    if (IN(4)) for (int rep_ = 0; rep_ < REPS(4); ++rep_) {
        pg8::Gemm g{HB, WT_in, TOK, 4608, 1024}; pg8::StaticOrder S; S.init(TOK, 4608, G_, c_);
        EpiQKV E{Qb}; pg8::gemm_phase<EpiQKV, pg8::StaticOrder>(lds, g, S, E, nullptr);
    }
    SEAM(4);
    if (IN(5)) for (int rep_ = 0; rep_ < REPS(5); ++rep_) attn_phase(lds, Qb, Kb, Vb, LSE, tid, lane, wave, rep_ + 1 < REPS(5));
    SEAM(5);
    if (IN(6)) for (int rep_ = 0; rep_ < REPS(6); ++rep_) combine_phase(Qb, LSE, ATT, OFB, OFB + (size_t)TOK * 1024, SHG, hgrn_ng, tid);
    SEAM(6);
    if (IN(7)) for (int rep_ = 0; rep_ < REPS(7); ++rep_) {
        pg8::StaticOrder S; S.init(TOK, 1024, G_, c_);
        { pg8::Gemm g{HB, WT_in + (size_t)9728 * 1024, TOK, 1024, 1024}; EpiMix<0> E{M1, nullptr}; pg8::gemm_phase<EpiMix<0>, pg8::StaticOrder>(lds, g, S, E, nullptr); }
        { pg8::Gemm g{ATT, WT_a, TOK, 1024, 512}; EpiMix<1> E{M1, nullptr}; pg8::gemm_phase<EpiMix<1>, pg8::StaticOrder>(lds, g, S, E, nullptr); }
        { pg8::Gemm g{HB, WT_in + (size_t)10752 * 1024, TOK, 1024, 1024}; EpiMix<0> E{M2, nullptr}; pg8::gemm_phase<EpiMix<0>, pg8::StaticOrder>(lds, g, S, E, nullptr); }
        { pg8::Gemm g{REC, WT_r, TOK, 1024, 1024}; EpiMix<2> E{M1, M2}; pg8::gemm_phase<EpiMix<2>, pg8::StaticOrder>(lds, g, S, E, nullptr); }
    }
    SEAM(7);
    if (IN(8)) for (int rep_ = 0; rep_ < REPS(8); ++rep_) {
        pg8::Gemm g{M1, WT_o, TOK, 1024, 1024}; pg8::StaticOrder S; S.init(TOK, 1024, G_, c_);
        EpiWo E{x, STATS, ln_in_g, ln_in_b, H1F}; pg8::gemm_phase<EpiWo, pg8::StaticOrder>(lds, g, S, E, nullptr);
    }
    SEAM(8);
    if (IN(9)) for (int rep_ = 0; rep_ < REPS(9); ++rep_) for (int m = gw; m < TOK; m += NGW) ln_row<true, true, false>(H1F + (size_t)m * 1024, ln1_g, ln1_b, H1F + (size_t)m * 1024, H1B + (size_t)m * 1024, nullptr, lane);
    SEAM(9);
    if (IN(10)) for (int rep_ = 0; rep_ < REPS(10); ++rep_) {
        pg8::Gemm g{H1B, WT_f1, TOK, 2 * DFF, 1024}; pg8::StaticOrder S; S.init(TOK, 2 * DFF, G_, c_);
        EpiFfnIn E{ACT}; pg8::gemm_phase<EpiFfnIn, pg8::StaticOrder>(lds, g, S, E, nullptr);
    }
    SEAM(10);
    if (IN(11)) for (int rep_ = 0; rep_ < REPS(11); ++rep_) {
        pg8::Gemm g{ACT, WT_f2, TOK, 1024, DFF}; pg8::StaticOrder S; S.init(TOK, 1024, G_, c_);
        EpiFfnOut E{H1F, a.out}; pg8::gemm_phase<EpiFfnOut, pg8::StaticOrder>(lds, g, S, E, nullptr);
    }
    SEAM(11);
    if (IN(12)) for (int rep_ = 0; rep_ < REPS(12); ++rep_) for (int m = gw; m < TOK; m += NGW) ln_row<true, false, false>(a.out + (size_t)m * 1024, ln2_g, ln2_b, a.out + (size_t)m * 1024, nullptr, nullptr, lane);
#undef IN
#undef SEAM
}

#ifndef MK_MULTI
#define MK_MULTI 0
#endif
extern "C" void kernel_launch(void* const* d_in, const int* in_sizes, int n_in, void* d_out, int out_size, void* d_ws, size_t ws_size, hipStream_t stream) {
    static int grid = 0;
    if (grid == 0) {
        int dev = 0, cus = 0, per_cu = 0;
        (void)hipGetDevice(&dev); (void)hipDeviceGetAttribute(&cus, hipDeviceAttributeMultiprocessorCount, dev);
        (void)hipFuncSetAttribute((const void*)mk_fwd, hipFuncAttributeMaxDynamicSharedMemorySize, LDS_BYTES);
        (void)hipOccupancyMaxActiveBlocksPerMultiprocessor(&per_cu, (const void*)mk_fwd, 512, LDS_BYTES);
        if (per_cu < 1) { fprintf(stderr, "kernel_launch: occupancy query says %d blocks per CU\n", per_cu); per_cu = 1; }
        grid = cus * 1;
        if (ws_size < 256 * MiB) fprintf(stderr, "kernel_launch: workspace too small (%zu)\n", ws_size);
    }
    Args a{};
    for (int i = 0; i < 15; ++i) a.in[i] = (const float*)d_in[i];
    a.out = (float*)d_out; a.ws = (unsigned char*)d_ws;
#if MK_MULTI
    for (int p = 0; p < NPHASE; ++p) { a.lo = p; a.hi = p + 1; hipLaunchKernelGGL(mk_fwd, dim3(grid), dim3(512), LDS_BYTES, stream, a); }
#else
    a.lo = 0; a.hi = NPHASE;
    (void)hipMemsetAsync((unsigned char*)d_ws + WS_BAR, 0, 16384, stream);
    void* args[] = {&a};
    hipError_t e = hipLaunchCooperativeKernel((const void*)mk_fwd, dim3(grid), dim3(512), args, LDS_BYTES, stream);
    if (e != hipSuccess) fprintf(stderr, "cooperative launch failed: %s (grid %d)\n", hipGetErrorString(e), grid);
#endif
}
```
